# Optimizing an MI355X kernel written in HIP

```python
import math
import jax, jax.numpy as jnp
from jax import lax
import numpy as np

D_MODEL = 1024
BATCH = 4
SEQ = 8192
DEPTH = 4

HEAD_DIM = 64
A_HEADS = 4
B_Q_HEADS = 8
B_KV_HEADS = 2
C_HEADS = 16
ROT_DIM = HEAD_DIM // 4
ROPE_THETA = 500000.0
AXIAL_THETA = 10000.0
GRID_W = 64
NA_KH = 8
NA_KW = 16
Q_BLOCK = 128
D_FF = 2816
CONV_W = 3
PLE_DIM = 256
EPS = 1e-6

N_EVEN = (DEPTH + 1) // 2
N_ODD = DEPTH // 2
A_QK = A_HEADS * 2 * HEAD_DIM
A_V = A_HEADS * 2 * HEAD_DIM
B_Q = B_Q_HEADS * HEAD_DIM
B_KV = B_KV_HEADS * HEAD_DIM
EVEN_IN = 2 * A_QK + A_V + B_Q + 2 * B_KV
EVEN_SPLITS = [A_QK, 2 * A_QK, 2 * A_QK + A_V, 2 * A_QK + A_V + B_Q, 2 * A_QK + A_V + B_Q + B_KV]
EVEN_MIX = A_V + B_Q
C_IN = 3 * C_HEADS * HEAD_DIM
C_MIX = C_HEADS * HEAD_DIM

kernel_name = "hybrid_diff_gqa_axial_natten_convffn_ple"


def rms_norm(x, g):
    xf = x.astype(jnp.float32)
    y = xf * lax.rsqrt(jnp.mean(xf * xf, axis=-1, keepdims=True) + EPS)
    return (y * g.astype(jnp.float32)).astype(x.dtype)


def rotary(x, pos, theta):
    d = x.shape[-1]
    half = d // 2
    inv = theta ** (-jnp.arange(half, dtype=jnp.float32) / half)
    ang = pos.astype(jnp.float32)[:, None] * inv[None, :]
    shp = (1, x.shape[1]) + (1,) * (x.ndim - 3) + (half,)
    cos = jnp.cos(ang).reshape(shp)
    sin = jnp.sin(ang).reshape(shp)
    xf = x.astype(jnp.float32)
    x1, x2 = xf[..., :half], xf[..., half:]
    return jnp.concatenate([x1 * cos - x2 * sin, x2 * cos + x1 * sin], axis=-1).astype(x.dtype)


def partial_rope(x, pos):
    return jnp.concatenate([rotary(x[..., :ROT_DIM], pos, ROPE_THETA), x[..., ROT_DIM:]], axis=-1)


def axial_rope(x, row, col):
    half = x.shape[-1] // 2
    return jnp.concatenate([rotary(x[..., :half], row, AXIAL_THETA),
                            rotary(x[..., half:], col, AXIAL_THETA)], axis=-1)


def to_blocks(t):
    b, s = t.shape[:2]
    return jnp.moveaxis(t.reshape((b, s // Q_BLOCK, Q_BLOCK) + t.shape[2:]), 1, 0)


def from_blocks(t):
    t = jnp.moveaxis(t, 0, 1)
    return t.reshape((t.shape[0], t.shape[1] * t.shape[2]) + t.shape[3:])


def diff_attention(q, k, v, lam):
    scale = HEAD_DIM ** -0.5

    def block(qb):
        s = jnp.einsum('bqhjd,bkhjd->bhjqk', qb, k).astype(jnp.float32) * scale
        pr = jax.nn.softmax(s, axis=-1)
        w = (pr[:, :, 0] - lam * pr[:, :, 1]).astype(v.dtype)
        return jnp.einsum('bhqk,bkhe->bqhe', w, v)

    return from_blocks(lax.map(block, to_blocks(q)))


def gqa_attention(q, k, v):
    scale = HEAD_DIM ** -0.5

    def block(qb):
        s = jnp.einsum('bqgrd,bkgd->bgrqk', qb, k).astype(jnp.float32) * scale
        pr = jax.nn.softmax(s, axis=-1).astype(v.dtype)
        return jnp.einsum('bgrqk,bkgd->bqgrd', pr, v)

    return from_blocks(lax.map(block, to_blocks(q)))


def neighbourhood_attention(q, k, v, bias_table):
    b, s, h, d = q.shape
    rows = s // GRID_W
    kh = min(NA_KH, rows)
    kw = NA_KW
    scale = d ** -0.5
    qg = q.reshape(b, rows, GRID_W, h, d)
    kg = k.reshape(b, rows, GRID_W, h, d)
    vg = v.reshape(b, rows, GRID_W, h, d)
    r_idx = jnp.arange(rows, dtype=jnp.int32)
    row_start = jnp.clip(r_idx - kh // 2, 0, rows - kh)
    cols = jnp.arange(GRID_W, dtype=jnp.int32)
    col_start = jnp.clip(cols - kw // 2, 0, GRID_W - kw)
    col_valid = (cols[None, :] >= col_start[:, None]) & (cols[None, :] < col_start[:, None] + kw)
    dc_idx = jnp.clip(cols[None, :] - cols[:, None] + NA_KW - 1, 0, 2 * NA_KW - 2)

    def row_block(args):
        r, rs, qr = args
        kr = lax.dynamic_slice_in_dim(kg, rs, kh, axis=1)
        vr = lax.dynamic_slice_in_dim(vg, rs, kh, axis=1)
        sc = jnp.einsum('bqhd,bjkhd->bhqjk', qr, kr).astype(jnp.float32) * scale
        dr_idx = rs + jnp.arange(kh, dtype=jnp.int32) - r + NA_KH - 1
        bias = bias_table[:, dr_idx[None, :, None], dc_idx[:, None, :]]
        sc = sc + bias.astype(jnp.float32)[None]
        sc = jnp.where(col_valid[:, None, :], sc, -jnp.inf)
        pr = jax.nn.softmax(sc, axis=(-2, -1)).astype(vr.dtype)
        return jnp.einsum('bhqjk,bjkhd->bqhd', pr, vr)

    out = lax.map(row_block, (r_idx, row_start, jnp.moveaxis(qg, 1, 0)))
    return jnp.moveaxis(out, 0, 1).reshape(b, s, h * d)


def even_mixer(h, w_in, lq1, lk1, lq2, lk2, subln, q_norm, k_norm, w_out, lam_init, pos, row, col):
    b, s, _ = h.shape
    a_q, a_k, a_v, b_q, b_k, b_v = jnp.split(h @ w_in, EVEN_SPLITS, axis=-1)
    a_q = partial_rope(a_q.reshape(b, s, 2 * A_HEADS, HEAD_DIM), pos).reshape(b, s, A_HEADS, 2, HEAD_DIM)
    a_k = partial_rope(a_k.reshape(b, s, 2 * A_HEADS, HEAD_DIM), pos).reshape(b, s, A_HEADS, 2, HEAD_DIM)
    a_v = a_v.reshape(b, s, A_HEADS, 2 * HEAD_DIM)
    f32 = jnp.float32
    lam = (jnp.exp(jnp.sum(lq1.astype(f32) * lk1.astype(f32)))
           - jnp.exp(jnp.sum(lq2.astype(f32) * lk2.astype(f32))) + lam_init)
    a_o = rms_norm(diff_attention(a_q, a_k, a_v, lam), subln) * (1.0 - lam_init)
    b_q = axial_rope(rms_norm(b_q.reshape(b, s, B_Q_HEADS, HEAD_DIM), q_norm), row, col)
    b_k = axial_rope(rms_norm(b_k.reshape(b, s, B_KV_HEADS, HEAD_DIM), k_norm), row, col)
    b_q = b_q.reshape(b, s, B_KV_HEADS, B_Q_HEADS // B_KV_HEADS, HEAD_DIM)
    b_v = b_v.reshape(b, s, B_KV_HEADS, HEAD_DIM)
    b_o = gqa_attention(b_q, b_k, b_v)
    mix = jnp.concatenate([a_o.reshape(b, s, A_V), b_o.reshape(b, s, B_Q)], axis=-1)
    return mix @ w_out


def odd_mixer(h, w_in, rel_bias, w_out):
    b, s, _ = h.shape
    q, k, v = jnp.split((h @ w_in).reshape(b, s, 3, C_HEADS, HEAD_DIM), 3, axis=2)
    o = neighbourhood_attention(q[:, :, 0], k[:, :, 0], v[:, :, 0], rel_bias)
    return o @ w_out


def conv_ffn(h, w_up, conv_w, conv_b, w_down):
    u = h @ w_up
    up = jnp.pad(u, ((0, 0), (1, 1), (0, 0)))
    u = up[:, :-2] * conv_w[0] + up[:, 1:-1] * conv_w[1] + up[:, 2:] * conv_w[2] + conv_b
    gate, val = jnp.split(u, 2, axis=-1)
    return (jax.nn.silu(gate) * val) @ w_down


def setup_inputs(seed: int = 0) -> dict:
    key = jax.random.key(seed)
    ks = jax.random.split(key, 26)
    nrm = lambda k, shape, scale: jax.random.normal(k, shape, jnp.float32) * scale
    gain = lambda k, shape: 1.0 + 0.02 * jax.random.normal(k, shape, jnp.float32)
    return {
        "x": nrm(ks[0], (BATCH, SEQ, D_MODEL), 1.0),
        "p": nrm(ks[1], (DEPTH, BATCH, SEQ, PLE_DIM), 1.0),
        "attn_norm": gain(ks[2], (DEPTH, D_MODEL)),
        "w_in_ab": nrm(ks[3], (N_EVEN, D_MODEL, EVEN_IN), D_MODEL ** -0.5),
        "lambda_q1": nrm(ks[4], (N_EVEN, HEAD_DIM), 0.1),
        "lambda_k1": nrm(ks[5], (N_EVEN, HEAD_DIM), 0.1),
        "lambda_q2": nrm(ks[6], (N_EVEN, HEAD_DIM), 0.1),
        "lambda_k2": nrm(ks[7], (N_EVEN, HEAD_DIM), 0.1),
        "a_subln": gain(ks[8], (N_EVEN, 2 * HEAD_DIM)),
        "b_q_norm": gain(ks[9], (N_EVEN, HEAD_DIM)),
        "b_k_norm": gain(ks[10], (N_EVEN, HEAD_DIM)),
        "w_out_ab": nrm(ks[11], (N_EVEN, EVEN_MIX, D_MODEL), EVEN_MIX ** -0.5),
        "w_in_c": nrm(ks[12], (N_ODD, D_MODEL, C_IN), D_MODEL ** -0.5),
        "c_rel_bias": nrm(ks[13], (N_ODD, C_HEADS, 2 * NA_KH - 1, 2 * NA_KW - 1), 0.02),
        "w_out_c": nrm(ks[14], (N_ODD, C_MIX, D_MODEL), C_MIX ** -0.5),
        "ffn_norm": gain(ks[15], (DEPTH, D_MODEL)),
        "w_ffn_up": nrm(ks[16], (DEPTH, D_MODEL, 2 * D_FF), D_MODEL ** -0.5),
        "ffn_conv_w": nrm(ks[17], (DEPTH, CONV_W, 2 * D_FF), CONV_W ** -0.5),
        "ffn_conv_b": nrm(ks[18], (DEPTH, 2 * D_FF), 0.02),
        "w_ffn_down": nrm(ks[19], (DEPTH, D_FF, D_MODEL), D_FF ** -0.5),
        "ple_norm": gain(ks[20], (DEPTH, D_MODEL)),
        "w_ple_gate": nrm(ks[21], (DEPTH, D_MODEL, D_MODEL), D_MODEL ** -0.5),
        "w_ple_proj": nrm(ks[22], (DEPTH, PLE_DIM, D_MODEL), PLE_DIM ** -0.5),
        "final_norm": gain(ks[23], (D_MODEL,)),
    }


def reference(x, p, attn_norm, w_in_ab, lambda_q1, lambda_k1, lambda_q2, lambda_k2, a_subln,
              b_q_norm, b_k_norm, w_out_ab, w_in_c, c_rel_bias, w_out_c, ffn_norm, w_ffn_up,
              ffn_conv_w, ffn_conv_b, w_ffn_down, ple_norm, w_ple_gate, w_ple_proj, final_norm):
    s = x.shape[1]
    pos = jnp.arange(s, dtype=jnp.int32)
    row = pos // GRID_W
    col = pos % GRID_W
    for i in range(DEPTH):
        j = i // 2
        h = rms_norm(x, attn_norm[i])
        if i % 2 == 0:
            lam_init = 0.8 - 0.6 * math.exp(-0.3 * i)
            y = even_mixer(h, w_in_ab[j], lambda_q1[j], lambda_k1[j], lambda_q2[j], lambda_k2[j],
                           a_subln[j], b_q_norm[j], b_k_norm[j], w_out_ab[j], lam_init, pos, row, col)
        else:
            y = odd_mixer(h, w_in_c[j], c_rel_bias[j], w_out_c[j])
        x = x + y
        x = x + conv_ffn(rms_norm(x, ffn_norm[i]), w_ffn_up[i], ffn_conv_w[i], ffn_conv_b[i], w_ffn_down[i])
        gate = jax.nn.sigmoid(rms_norm(x, ple_norm[i]) @ w_ple_gate[i])
        x = x + gate * (p[i] @ w_ple_proj[i])
    return rms_norm(x, final_norm)
```

```cpp
#include <hip/hip_runtime.h>
#include <hip/hip_cooperative_groups.h>
#include <cstdio>
#include <cmath>
#include <cstdint>
namespace cg = cooperative_groups;

typedef unsigned short bf16_t;
typedef short bf16x8 __attribute__((ext_vector_type(8)));
typedef float f32x16 __attribute__((ext_vector_type(16)));
typedef float f32x4 __attribute__((ext_vector_type(4)));
typedef float f32x2 __attribute__((ext_vector_type(2)));
typedef unsigned u32x4 __attribute__((ext_vector_type(4)));
typedef unsigned u32x2 __attribute__((ext_vector_type(2)));
typedef __bf16 bf16v2 __attribute__((ext_vector_type(2)));

#define DI __device__ __forceinline__

constexpr int T_TOK = 32768, SEQ = 8192, DM = 1024, DFF = 2816, PLE = 256;
constexpr float EPS = 1e-6f;
constexpr float QSCALE = 0.125f * 1.4426950408889634f;
constexpr float LOG2E = 1.4426950408889634f;
constexpr int NTHREADS = 512;
constexpr int LROW = 144;
constexpr int GT_BYTES = 256 * LROW;
constexpr int LDS_BYTES = 4 * GT_BYTES + 8192 + 512;

constexpr size_t MiB = 1024 * 1024;
constexpr size_t OFF_ROPEA = 0;
constexpr size_t OFF_ROPEB = 524288;
constexpr size_t OFF_BAR = 640 * 1024;
constexpr size_t OFF_WB = 1 * MiB;
constexpr size_t WL_WIN = 0, WL_WOUT = 3145728, WL_WUP = WL_WOUT + 1048576, WL_WDOWN = WL_WUP + 5767168,
                 WL_WGATE = WL_WDOWN + 2883584, WL_WPROJ = WL_WGATE + 1048576, WL_ELEMS = WL_WPROJ + 262144;
constexpr size_t OFF_H = OFF_WB + 108 * MiB;
constexpr size_t OFF_QKB = OFF_H + 64 * MiB;
constexpr size_t OFF_VT = OFF_QKB + 128 * MiB;
constexpr size_t OFF_ACT = OFF_QKB;
constexpr size_t OFF_MIX = OFF_VT + 64 * MiB;
constexpr size_t OFF_HALO = OFF_MIX + 64 * MiB;
constexpr size_t OFF_PB = OFF_HALO + 22 * MiB;
constexpr size_t OFF_SSQ = OFF_PB + 16 * MiB;
constexpr size_t WS_NEEDED = OFF_SSQ + 26 * MiB;
static_assert(WL_ELEMS * 2 * 4 <= 108 * MiB, "weights");
constexpr int QLD = 2048;
constexpr int SREG_BYTES = 18432;

struct Params {
    const float* x; const float* p; const float* attn_norm; const float* w_in_ab;
    const float* lq1; const float* lk1; const float* lq2; const float* lk2;
    const float* a_subln; const float* bq_norm; const float* bk_norm; const float* w_out_ab;
    const float* w_in_c; const float* c_rel_bias; const float* w_out_c; const float* ffn_norm;
    const float* w_ffn_up; const float* conv_w; const float* conv_b; const float* w_ffn_down;
    const float* ple_norm; const float* w_ple_gate; const float* w_ple_proj; const float* final_norm;
    float* out; char* ws;
    float inv_a[8]; float inv_b[16]; float lam_init[4];
};

DI unsigned pk2(float lo, float hi) { f32x2 v = {lo, hi}; return __builtin_bit_cast(unsigned, __builtin_convertvector(v, bf16v2)); }
DI float bf2f(bf16_t b) { return __uint_as_float(((unsigned)b) << 16); }
DI f32x16 mfma32(bf16x8 a, bf16x8 b, f32x16 c) { return __builtin_amdgcn_mfma_f32_32x32x16_bf16(a, b, c, 0, 0, 0); }
DI float fexp2(float x) { return __builtin_amdgcn_exp2f(x); }
DI float frcp(float x) { return __builtin_amdgcn_rcpf(x); }
DI float xhalf_max(float x) { return fmaxf(x, __shfl_xor(x, 32)); }
DI float xhalf_sum(float x) { return x + __shfl_xor(x, 32); }
DI float sigmoidf_(float x) { return frcp(1.0f + fexp2(-x * LOG2E)); }

DI int tidx() { int t = threadIdx.x; asm volatile("" : "+v"(t)); return t; }

template <bool PERM_UP>
DI void convert_weight(char* lds, const float* __restrict__ src, bf16_t* __restrict__ dst, int K, int N, const float* __restrict__ gain = nullptr) {
    float* tile = (float*)lds;
    const int tid = tidx();
    const int ntk = K / 64, ntn = N / 64, nt = ntk * ntn;
    for (int t = blockIdx.x; t < nt; t += gridDim.x) {
        const int k0 = (t / ntn) * 64, n0 = (t % ntn) * 64;
#pragma unroll
        for (int i = 0; i < 8; ++i) { const int idx = tid + NTHREADS * i, k = idx >> 6, n = idx & 63; tile[k * 65 + n] = src[(size_t)(k0 + k) * N + n0 + n] * (gain ? gain[k0 + k] : 1.0f); }
        __syncthreads();
#pragma unroll
        for (int i = 0; i < 4; ++i) {
            const int idx = tid + NTHREADS * i, n = idx >> 5, k2 = idx & 31;
            int nn = n0 + n;
            if (PERM_UP) { const int c = nn < DFF ? nn : nn - DFF; nn = (c >> 5) * 64 + (nn < DFF ? 0 : 32) + (c & 31); }
            *(unsigned*)(dst + (size_t)nn * K + k0 + 2 * k2) = pk2(tile[(2 * k2) * 65 + n], tile[(2 * k2 + 1) * 65 + n]);
        }
        __syncthreads();
    }
}

DI void sincos_acc(float angf, float& sn, float& cs) {
    const double x = (double)angf;
    const double k = __builtin_rint(x * 0.15915494309189535);
    double y = __builtin_fma(-k, 6.283185307179586, x); y = __builtin_fma(-k, 2.4492935982947064e-16, y);
    const double y2 = y * y;
    double ts = y, s = y, tc = 1.0, c = 1.0;
#pragma unroll 1
    for (int n = 1; n <= 14; ++n) {
        tc *= -y2 / (double)((2 * n - 1) * (2 * n)); c += tc;
        ts *= -y2 / (double)((2 * n) * (2 * n + 1)); s += ts;
    }
    sn = (float)s; cs = (float)c;
}

DI void phase_prep(const Params& P, char* lds) {
    bf16_t* wb = (bf16_t*)(P.ws + OFF_WB);
    for (int l = 0; l < 4; ++l) {
        bf16_t* wl = wb + (size_t)l * WL_ELEMS; const int j = l >> 1;
        if ((l & 1) == 0) { convert_weight<false>(lds, P.w_in_ab + (size_t)j * 1024 * 2304, wl + WL_WIN, 1024, 2304, P.attn_norm + l * DM); convert_weight<false>(lds, P.w_out_ab + (size_t)j * 1024 * 1024, wl + WL_WOUT, 1024, 1024); }
        else { convert_weight<false>(lds, P.w_in_c + (size_t)j * 1024 * 3072, wl + WL_WIN, 1024, 3072, P.attn_norm + l * DM); convert_weight<false>(lds, P.w_out_c + (size_t)j * 1024 * 1024, wl + WL_WOUT, 1024, 1024); }
        convert_weight<true>(lds, P.w_ffn_up + (size_t)l * 1024 * 5632, wl + WL_WUP, 1024, 5632, P.ffn_norm + l * DM);
        convert_weight<false>(lds, P.w_ffn_down + (size_t)l * 2816 * 1024, wl + WL_WDOWN, 2816, 1024);
        convert_weight<false>(lds, P.w_ple_gate + (size_t)l * 1024 * 1024, wl + WL_WGATE, 1024, 1024, P.ple_norm + l * DM);
        convert_weight<false>(lds, P.w_ple_proj + (size_t)l * 256 * 1024, wl + WL_WPROJ, 256, 1024);
    }
    f32x2* ra = (f32x2*)(P.ws + OFF_ROPEA); f32x2* rb = (f32x2*)(P.ws + OFF_ROPEB);
    for (int i = blockIdx.x * NTHREADS + tidx(); i < 8192 + 128; i += gridDim.x * NTHREADS) {
        float sn, cs;
        if (i < 8192) {
#pragma unroll
            for (int k = 0; k < 8; ++k) { const float ang = (float)i * P.inv_a[k]; sincos_acc(ang, sn, cs); ra[i * 8 + k] = (f32x2){cs, sn}; }
        } else {
            const int q = i - 8192;
#pragma unroll
            for (int k = 0; k < 16; ++k) { const float ang = (float)q * P.inv_b[k]; sincos_acc(ang, sn, cs); rb[q * 16 + k] = (f32x2){cs, sn}; }
        }
    }
}

DI void phase_x0(const float* __restrict__ src, bf16_t* __restrict__ dst, float* __restrict__ ssq) {
    const int lane = tidx() & 63, wv = blockIdx.x * 8 + (tidx() >> 6), nw = gridDim.x * 8;
    for (int row = wv; row < T_TOK; row += nw) {
        const float* sp = src + (size_t)row * DM; f32x4 v[4]; float ss = 0.f;
#pragma unroll
        for (int i = 0; i < 4; ++i) { v[i] = *(const f32x4*)(sp + (i * 64 + lane) * 4); ss += v[i][0] * v[i][0] + v[i][1] * v[i][1] + v[i][2] * v[i][2] + v[i][3] * v[i][3]; }
#pragma unroll
        for (int o = 32; o >= 1; o >>= 1) ss += __shfl_xor(ss, o);
#pragma unroll
        for (int i = 0; i < 4; ++i) { u32x2 w; w.x = pk2(v[i][0], v[i][1]); w.y = pk2(v[i][2], v[i][3]); *(u32x2*)(dst + (size_t)row * DM + (i * 64 + lane) * 4) = w; }
        if (lane < 16) ssq[(size_t)lane * T_TOK + row] = lane == 0 ? ss : 0.f;
    }
}
DI float rstd_of(float ssq) { return __builtin_amdgcn_rsqf(ssq * (1.0f / DM) + EPS); }
DI float* wave_rstd_table(const float* __restrict__ ssqp, int tok0w, const char* xtra, int lane) {
    float* tbl = (float*)(xtra + 4096) + (tidx() >> 6) * 128;
    {
        const float* p = ssqp + tok0w + 2 * lane;
        f32x2 a[16];
#pragma unroll
        for (int i = 0; i < 16; ++i) a[i] = *(const f32x2*)(p + (size_t)i * T_TOK);
        const f32x2 t = (((a[0] + a[1]) + (a[2] + a[3])) + ((a[4] + a[5]) + (a[6] + a[7]))) + (((a[8] + a[9]) + (a[10] + a[11])) + ((a[12] + a[13]) + (a[14] + a[15])));
        *(f32x2*)(tbl + 2 * lane) = (f32x2){rstd_of(t.x), rstd_of(t.y)};
    }
    return tbl;
}

DI void phase_norm(const float* __restrict__ src, const float* __restrict__ g, bf16_t* __restrict__ dst) {
    const int lane = tidx() & 63, wv = blockIdx.x * 8 + (tidx() >> 6), nw = gridDim.x * 8;
    f32x4 gv[4];
#pragma unroll
    for (int i = 0; i < 4; ++i) gv[i] = *(const f32x4*)(g + (i * 64 + lane) * 4);
    for (int row = wv; row < T_TOK; row += nw) {
        const float* s = src + (size_t)row * DM; f32x4 v[4]; float ss = 0.f;
#pragma unroll
        for (int i = 0; i < 4; ++i) { v[i] = *(const f32x4*)(s + (i * 64 + lane) * 4); ss += v[i][0] * v[i][0] + v[i][1] * v[i][1] + v[i][2] * v[i][2] + v[i][3] * v[i][3]; }
#pragma unroll
        for (int o = 32; o >= 1; o >>= 1) ss += __shfl_xor(ss, o);
        const float rs = __builtin_amdgcn_rsqf(ss * (1.0f / DM) + EPS);
#pragma unroll
        for (int i = 0; i < 4; ++i) { u32x2 w; w.x = pk2(v[i][0] * rs * gv[i][0], v[i][1] * rs * gv[i][1]); w.y = pk2(v[i][2] * rs * gv[i][2], v[i][3] * rs * gv[i][3]); *(u32x2*)(dst + (size_t)row * DM + (i * 64 + lane) * 4) = w; }
    }
}
DI void phase_final_norm(float* __restrict__ x, const float* __restrict__ g) {
    const int lane = tidx() & 63, wv = blockIdx.x * 8 + (tidx() >> 6), nw = gridDim.x * 8;
    f32x4 gv[4];
#pragma unroll
    for (int i = 0; i < 4; ++i) gv[i] = *(const f32x4*)(g + (i * 64 + lane) * 4);
    for (int row = wv; row < T_TOK; row += nw) {
        float* s = x + (size_t)row * DM; f32x4 v[4]; float ss = 0.f;
#pragma unroll
        for (int i = 0; i < 4; ++i) { v[i] = *(const f32x4*)(s + (i * 64 + lane) * 4); ss += v[i][0] * v[i][0] + v[i][1] * v[i][1] + v[i][2] * v[i][2] + v[i][3] * v[i][3]; }
#pragma unroll
        for (int o = 32; o >= 1; o >>= 1) ss += __shfl_xor(ss, o);
        const float rs = __builtin_amdgcn_rsqf(ss * (1.0f / DM) + EPS);
#pragma unroll
        for (int i = 0; i < 4; ++i) *(f32x4*)(s + (i * 64 + lane) * 4) = v[i] * rs * gv[i];
    }
}
DI void phase_cvt_p(const float* __restrict__ src, bf16_t* __restrict__ dst) {
    const size_t n4 = (size_t)T_TOK * PLE / 4;
    for (size_t i = (size_t)blockIdx.x * NTHREADS + tidx(); i < n4; i += (size_t)gridDim.x * NTHREADS) {
        const f32x4 v = *(const f32x4*)(src + i * 4); u32x2 w; w.x = pk2(v[0], v[1]); w.y = pk2(v[2], v[3]); *(u32x2*)(dst + i * 4) = w;
    }
}

template <class Epi, bool SWP>
DI void gemm_tile(char* lds, const bf16_t* __restrict__ A, int lda, const bf16_t* __restrict__ Bt, int K, int tok0, int col0, const Epi& epi) {
    const int tid = tidx(), lane = tid & 63, wid = __builtin_amdgcn_readfirstlane(tid >> 6), wm = wid & 1, wn = wid >> 1, r = lane & 31, h = lane >> 5;
    const int lrow = tid >> 3, lkc = tid & 7;
    const char* abase = (const char*)(A + (size_t)tok0 * lda); const char* bbase = (const char*)(Bt + (size_t)col0 * K);
    const unsigned voa = (unsigned)(lrow * lda + lkc * 8) * 2u, vob = (unsigned)(lrow * K + lkc * 8) * 2u;
    const int lw = lrow * LROW + lkc * 16;
    int lwa[4];
#pragma unroll
    for (int i = 0; i < 4; ++i) {
        if (Epi::PERM_TOK) { const int gr = lrow + 64 * i, tau = gr & 127; lwa[i] = ((gr & 128) + (tau & 3) * 32 + (tau >> 2)) * LROW + lkc * 16; }
        else lwa[i] = lw + 64 * i * LROW;
    }
    u32x4 ra[4], rb[4];
#pragma unroll
    for (int i = 0; i < 4; ++i) { ra[i] = *(const u32x4*)(abase + (size_t)(64 * i) * lda * 2 + voa); rb[i] = *(const u32x4*)(bbase + (size_t)(64 * i) * K * 2 + vob); }
    epi.tile_prologue(lds, col0, tid);
    f32x16 acc[2][4];
#pragma unroll
    for (int a = 0; a < 2; ++a)
#pragma unroll
        for (int b = 0; b < 4; ++b)
#pragma unroll
            for (int i = 0; i < 16; ++i) acc[a][b][i] = 0.f;
#pragma unroll
    for (int i = 0; i < 4; ++i) { *(u32x4*)(lds + lwa[i]) = ra[i]; *(u32x4*)(lds + GT_BYTES + lw + 64 * i * LROW) = rb[i]; }
    __syncthreads();
    const int nk = K / 64;
    if (nk > 1) {
#pragma unroll
        for (int i = 0; i < 4; ++i) { ra[i] = *(const u32x4*)(abase + ((size_t)(64 * i) * lda + 64) * 2 + voa); rb[i] = *(const u32x4*)(bbase + ((size_t)(64 * i) * K + 64) * 2 + vob); }
    }
#define GBAR() do { asm volatile("s_waitcnt lgkmcnt(0)" ::: "memory"); __builtin_amdgcn_s_barrier(); asm volatile("" ::: "memory"); __builtin_amdgcn_sched_barrier(0); } while (0)
    const int grp = wid >> 2;
    if (grp == 1) GBAR();
#pragma unroll 1
    for (int kt = 0; kt < nk; ++kt) {
        const bool more = kt + 1 < nk, more2 = kt + 2 < nk;
        const char* sa = lds + (kt & 1) * 2 * GT_BYTES + (wm * 128 + r) * LROW + h * 16;
        const char* sb = lds + (kt & 1) * 2 * GT_BYTES + GT_BYTES + (wn * 64 + r) * LROW + h * 16;
        bf16x8 wf[2][2], xf[2][4];
#pragma unroll 1
        for (int hs = 0; hs < 2; ++hs) {
#pragma unroll
            for (int q = 0; q < 2; ++q) {
#pragma unroll
                for (int fb = 0; fb < 2; ++fb) wf[q][fb] = *(const bf16x8*)(sb + fb * 32 * LROW + (2 * hs + q) * 32);
#pragma unroll
                for (int tb = 0; tb < 4; ++tb) xf[q][tb] = *(const bf16x8*)(sa + tb * 32 * LROW + (2 * hs + q) * 32);
            }
            if (hs == 1 && more) {
                char* d = lds + ((kt + 1) & 1) * 2 * GT_BYTES;
                int tl = tidx();
                const int lrow2 = tl >> 3, lkc2 = tl & 7;
#pragma unroll
                for (int i = 0; i < 4; ++i) {
                    int oa;
                    if (Epi::PERM_TOK) { const int gr = lrow2 + 64 * i, tau = gr & 127; oa = ((gr & 128) + (tau & 3) * 32 + (tau >> 2)) * LROW + lkc2 * 16; }
                    else oa = (lrow2 + 64 * i) * LROW + lkc2 * 16;
                    *(u32x4*)(d + oa) = ra[i]; *(u32x4*)(d + GT_BYTES + (lrow2 + 64 * i) * LROW + lkc2 * 16) = rb[i];
                }
                if (more2) {
                    const unsigned voa2 = (unsigned)(lrow2 * lda + lkc2 * 8) * 2u, vob2 = (unsigned)(lrow2 * K + lkc2 * 8) * 2u;
#pragma unroll
                    for (int i = 0; i < 4; ++i) { ra[i] = *(const u32x4*)(abase + ((size_t)(64 * i) * lda + (kt + 2) * 64) * 2 + voa2); rb[i] = *(const u32x4*)(bbase + ((size_t)(64 * i) * K + (kt + 2) * 64) * 2 + vob2); }
                }
            }
            GBAR();
            __builtin_amdgcn_s_setprio(1);
#pragma unroll
            for (int q = 0; q < 2; ++q)
#pragma unroll
                for (int fb = 0; fb < 2; ++fb)
#pragma unroll
                    for (int tb = 0; tb < 4; ++tb) acc[fb][tb] = SWP ? mfma32(wf[q][fb], xf[q][tb], acc[fb][tb]) : mfma32(xf[q][tb], wf[q][fb], acc[fb][tb]);
            __builtin_amdgcn_s_setprio(0);
            GBAR();
        }
    }
    if (grp == 0) GBAR();
#undef GBAR
    char* sreg = lds + wid * SREG_BYTES;
    if (SWP) epi.swp(acc, tok0 + wm * 128, col0 + wn * 64, r, h, sreg, lds + 4 * GT_BYTES); else epi.nsw(acc, tok0 + wm * 128, col0 + wn * 64, r, h, sreg, lds + 4 * GT_BYTES);
    if (Epi::STAGED) __syncthreads();
}

template <class Epi>
DI void gemm_phase(char* lds, const bf16_t* A, int lda, const bf16_t* Bt, int K, int N, const Epi& epi, int vbid) {
    const int nN = N / 256;
    const int wn = __builtin_amdgcn_readfirstlane(tidx() >> 7);
    const int G = gridDim.x, bid = vbid;
    if ((G & 7) == 0) {
        const int x = bid & 7, per = G >> 3, nq = 16 * nN;
        for (int q = bid >> 3; q < nq; q += per) {
            const int tok0 = (16 * x + (q & 7) + 8 * (q / (8 * nN))) * 256, col0 = ((q >> 3) % nN) * 256;
            if (!Epi::HAS_NSW || epi.swapped(col0 + wn * 64)) gemm_tile<Epi, true>(lds, A, lda, Bt, K, tok0, col0, epi);
            else gemm_tile<Epi, false>(lds, A, lda, Bt, K, tok0, col0, epi);
        }
    } else {
        const int nU = (T_TOK / 256) * nN;
        for (int u = bid; u < nU; u += G) {
            const int tok0 = (u / nN) * 256, col0 = (u % nN) * 256;
            if (!Epi::HAS_NSW || epi.swapped(col0 + wn * 64)) gemm_tile<Epi, true>(lds, A, lda, Bt, K, tok0, col0, epi);
            else gemm_tile<Epi, false>(lds, A, lda, Bt, K, tok0, col0, epi);
        }
    }
}

DI void st_bf4(bf16_t* p, float a, float b, float c, float d) { u32x2 w; w.x = pk2(a, b); w.y = pk2(c, d); *(u32x2*)p = w; }
DI void lds_put4(char* p, float a, float b, float c, float d) { u32x2 w; w.x = pk2(a, b); w.y = pk2(c, d); *(u32x2*)p = w; }
template <int NROWS, int ROWB, bool SKIP_EDGES>
DI void stage_flush(const char* sreg, int lane, bf16_t* gbase, size_t gstride) {
    constexpr int CPR = ROWB / 16, TOTAL = NROWS * CPR;
    static_assert(NROWS * (ROWB + 16) <= SREG_BYTES, "staging region");
#pragma unroll
    for (int i = 0; i < TOTAL / 64; ++i) {
        const int idx = lane + 64 * i, row = idx / CPR, ch = idx % CPR;
        const u32x4 v = *(const u32x4*)(sreg + row * (ROWB + 16) + ch * 16);
        if (!SKIP_EDGES || (row != 0 && row != NROWS - 1)) *(u32x4*)(gbase + (size_t)row * gstride + ch * 8) = v;
    }
}

struct EpiInEven {
    bf16_t* qkb; bf16_t* avt; bf16_t* bvt; const f32x2* ropea; const f32x2* ropeb; const float* qn; const float* kn; const float* ssq;
    static constexpr bool HAS_NSW = true, PERM_TOK = false, STAGED = true;
    DI void tile_prologue(char*, int, int) const {}
    DI bool swapped(int f0) const { return !((f0 >= 1024 && f0 < 1536) || f0 >= 2176); }
    DI void nsw(f32x16 (&acc)[2][4], int tok0w, int f0w, int r, int h, char* sreg, const char* xtra) const {
        {
            const float* tbl = wave_rstd_table(ssq, tok0w, xtra, 32 * h + r);
#pragma unroll
            for (int tb = 0; tb < 4; ++tb)
#pragma unroll
                for (int g = 0; g < 4; ++g) { const f32x4 q = *(const f32x4*)(tbl + 32 * tb + 8 * g + 4 * h);
#pragma unroll
                    for (int e = 0; e < 4; ++e) { acc[0][tb][4 * g + e] *= q[e]; acc[1][tb][4 * g + e] *= q[e]; } }
        }
        {
            bf16_t* base; int drow0;
            if (f0w < 1536) { const int c = f0w - 1024; base = avt; drow0 = ((tok0w >> 13) * 4 + (c >> 7)) * 128 + (c & 127); }
            else { const int c = f0w - 2176; base = bvt; drow0 = ((tok0w >> 13) * 2 + (c >> 6)) * 64; }
            const int s0 = tok0w & (SEQ - 1);
#pragma unroll
            for (int fb = 0; fb < 2; ++fb)
#pragma unroll
                for (int tb = 0; tb < 4; ++tb)
#pragma unroll
                    for (int g = 0; g < 4; ++g)
                        lds_put4(sreg + (32 * fb + r) * 272 + (32 * tb + 8 * g + 4 * h) * 2, acc[fb][tb][4 * g], acc[fb][tb][4 * g + 1], acc[fb][tb][4 * g + 2], acc[fb][tb][4 * g + 3]);
            stage_flush<64, 256, false>(sreg, 32 * h + r, base + (size_t)drow0 * SEQ + s0, SEQ);
        }
    }
    DI void swp(f32x16 (&acc)[2][4], int tok0w, int f0w, int r, int h, char* sreg, const char* xtra) const {
        {
            const float* tbl = wave_rstd_table(ssq, tok0w, xtra, 32 * h + r);
#pragma unroll
            for (int tb = 0; tb < 4; ++tb) { const float rs = tbl[32 * tb + r];
#pragma unroll
                for (int fb = 0; fb < 2; ++fb)
#pragma unroll
                    for (int i = 0; i < 16; ++i) acc[fb][tb][i] *= rs; }
        }
        if (f0w < 1024) {
            const float sc = f0w < 512 ? QSCALE : 1.0f;
#pragma unroll
            for (int tb = 0; tb < 4; ++tb) {
                const int t = tok0w + 32 * tb + r, s = t & (SEQ - 1);
                const f32x4 cs0 = *(const f32x4*)(ropea + s * 8 + 4 * h), cs1 = *(const f32x4*)(ropea + s * 8 + 4 * h + 2);
                const float c[4] = {cs0[0], cs0[2], cs1[0], cs1[2]}, sn[4] = {cs0[1], cs0[3], cs1[1], cs1[3]};
#pragma unroll
                for (int e = 0; e < 4; ++e) { const float x1 = acc[0][tb][e], x2 = acc[0][tb][4 + e]; acc[0][tb][e] = x1 * c[e] - x2 * sn[e]; acc[0][tb][4 + e] = x2 * c[e] + x1 * sn[e]; }
#pragma unroll
                for (int fb = 0; fb < 2; ++fb)
#pragma unroll
                    for (int g = 0; g < 4; ++g)
                        lds_put4(sreg + (32 * tb + r) * 144 + (32 * fb + 8 * g + 4 * h) * 2, acc[fb][tb][4 * g] * sc, acc[fb][tb][4 * g + 1] * sc, acc[fb][tb][4 * g + 2] * sc, acc[fb][tb][4 * g + 3] * sc);
            }
            stage_flush<128, 128, false>(sreg, 32 * h + r, qkb + (size_t)tok0w * QLD + f0w, QLD);
            return;
        }
        const bool isq = f0w < 2048; const float sc = isq ? QSCALE : 1.0f; const float* gn = isq ? qn : kn;
        const int ocol = isq ? (1024 + f0w - 1536) : (1536 + f0w - 2048);
        f32x4 gv[2][4];
#pragma unroll
        for (int fb = 0; fb < 2; ++fb)
#pragma unroll
            for (int g = 0; g < 4; ++g) gv[fb][g] = *(const f32x4*)(gn + 32 * fb + 8 * g + 4 * h);
#pragma unroll
        for (int tb = 0; tb < 4; ++tb) {
            const int t = tok0w + 32 * tb + r, s = t & (SEQ - 1);
            float ss = 0.f;
#pragma unroll
            for (int fb = 0; fb < 2; ++fb)
#pragma unroll
                for (int i = 0; i < 16; ++i) ss += acc[fb][tb][i] * acc[fb][tb][i];
            ss += __shfl_xor(ss, 32);
            const float rs = __builtin_amdgcn_rsqf(ss * (1.0f / 64.0f) + EPS);
#pragma unroll
            for (int fb = 0; fb < 2; ++fb)
#pragma unroll
                for (int g = 0; g < 4; ++g)
#pragma unroll
                    for (int e = 0; e < 4; ++e) acc[fb][tb][4 * g + e] *= rs * gv[fb][g][e];
#pragma unroll
            for (int fb = 0; fb < 2; ++fb) {
                const int pos = fb == 0 ? (s >> 6) : (s & 63);
#pragma unroll
                for (int g = 0; g < 2; ++g) {
                    const f32x4 cs0 = *(const f32x4*)(ropeb + pos * 16 + 8 * g + 4 * h), cs1 = *(const f32x4*)(ropeb + pos * 16 + 8 * g + 4 * h + 2);
                    const float c[4] = {cs0[0], cs0[2], cs1[0], cs1[2]}, sn[4] = {cs0[1], cs0[3], cs1[1], cs1[3]};
#pragma unroll
                    for (int e = 0; e < 4; ++e) { const float x1 = acc[fb][tb][4 * g + e], x2 = acc[fb][tb][4 * (g + 2) + e]; acc[fb][tb][4 * g + e] = x1 * c[e] - x2 * sn[e]; acc[fb][tb][4 * (g + 2) + e] = x2 * c[e] + x1 * sn[e]; }
                }
            }
#pragma unroll
            for (int fb = 0; fb < 2; ++fb)
#pragma unroll
                for (int g = 0; g < 4; ++g)
                    lds_put4(sreg + (32 * tb + r) * 144 + (32 * fb + 8 * g + 4 * h) * 2, acc[fb][tb][4 * g] * sc, acc[fb][tb][4 * g + 1] * sc, acc[fb][tb][4 * g + 2] * sc, acc[fb][tb][4 * g + 3] * sc);
        }
        stage_flush<128, 128, false>(sreg, 32 * h + r, qkb + (size_t)tok0w * QLD + ocol, QLD);
    }
};

struct EpiInOdd {
    bf16_t* qkb; bf16_t* cvt; const float* ssq;
    static constexpr bool HAS_NSW = true, PERM_TOK = false, STAGED = true;
    DI void tile_prologue(char*, int, int) const {}
    DI bool swapped(int f0) const { return f0 < 2048; }
    DI void nsw(f32x16 (&acc)[2][4], int tok0w, int f0w, int r, int h, char* sreg, const char* xtra) const {
        {
            const float* tbl = wave_rstd_table(ssq, tok0w, xtra, 32 * h + r);
#pragma unroll
            for (int tb = 0; tb < 4; ++tb)
#pragma unroll
                for (int g = 0; g < 4; ++g) { const f32x4 q = *(const f32x4*)(tbl + 32 * tb + 8 * g + 4 * h);
#pragma unroll
                    for (int e = 0; e < 4; ++e) { acc[0][tb][4 * g + e] *= q[e]; acc[1][tb][4 * g + e] *= q[e]; } }
        }
        {
            const int c = f0w - 2048; const int drow0 = ((tok0w >> 13) * 16 + (c >> 6)) * 64; const int s0 = tok0w & (SEQ - 1);
#pragma unroll
            for (int fb = 0; fb < 2; ++fb)
#pragma unroll
                for (int tb = 0; tb < 4; ++tb)
#pragma unroll
                    for (int g = 0; g < 4; ++g)
                        lds_put4(sreg + (32 * fb + r) * 272 + (32 * tb + 8 * g + 4 * h) * 2, acc[fb][tb][4 * g], acc[fb][tb][4 * g + 1], acc[fb][tb][4 * g + 2], acc[fb][tb][4 * g + 3]);
            stage_flush<64, 256, false>(sreg, 32 * h + r, cvt + (size_t)drow0 * SEQ + s0, SEQ);
        }
    }
    DI void swp(f32x16 (&acc)[2][4], int tok0w, int f0w, int r, int h, char* sreg, const char* xtra) const {
        {
            const float* tbl = wave_rstd_table(ssq, tok0w, xtra, 32 * h + r);
#pragma unroll
            for (int tb = 0; tb < 4; ++tb) { const float rs = tbl[32 * tb + r];
#pragma unroll
                for (int fb = 0; fb < 2; ++fb)
#pragma unroll
                    for (int i = 0; i < 16; ++i) acc[fb][tb][i] *= rs; }
        }
        const float sc = f0w < 1024 ? QSCALE : 1.0f;
#pragma unroll
        for (int tb = 0; tb < 4; ++tb) {
            const int t = tok0w + 32 * tb + r;
#pragma unroll
            for (int fb = 0; fb < 2; ++fb)
#pragma unroll
                for (int g = 0; g < 4; ++g)
                    lds_put4(sreg + (32 * tb + r) * 144 + (32 * fb + 8 * g + 4 * h) * 2, acc[fb][tb][4 * g] * sc, acc[fb][tb][4 * g + 1] * sc, acc[fb][tb][4 * g + 2] * sc, acc[fb][tb][4 * g + 3] * sc);
        }
        stage_flush<128, 128, false>(sreg, 32 * h + r, qkb + (size_t)tok0w * QLD + f0w, QLD);
    }
};

struct EpiResid {
    const float* res; float* out; bf16_t* xb; float* ssq;
    static constexpr bool HAS_NSW = false, PERM_TOK = false, STAGED = true;
    DI void tile_prologue(char*, int, int) const {}
    DI bool swapped(int) const { return true; }
    DI void nsw(f32x16 (&)[2][4], int, int, int, int, char*, const char*) const {}
    DI void swp(f32x16 (&acc)[2][4], int tok0w, int f0w, int r, int h, char* sreg, const char* xtra) const {
        f32x4 rv[2][8];
        const size_t base = (size_t)(tok0w + r) * DM + f0w + 4 * h;
#pragma unroll
        for (int q = 0; q < 8; ++q) rv[0][q] = *(const f32x4*)(res + base + 32 * (q >> 2) + 8 * (q & 3));
#pragma unroll
        for (int tb = 0; tb < 4; ++tb) {
            if (tb < 3) {
#pragma unroll
                for (int q = 0; q < 8; ++q) rv[(tb + 1) & 1][q] = *(const f32x4*)(res + base + (size_t)(32 * (tb + 1)) * DM + 32 * (q >> 2) + 8 * (q & 3));
            }
            float ss = 0.f;
#pragma unroll
            for (int q = 0; q < 8; ++q) {
                const int fb = q >> 2, g = q & 3; const f32x4 c = rv[tb & 1][q];
                f32x4 v = {acc[fb][tb][4 * g] + c[0], acc[fb][tb][4 * g + 1] + c[1], acc[fb][tb][4 * g + 2] + c[2], acc[fb][tb][4 * g + 3] + c[3]};
                *(f32x4*)(out + base + (size_t)(32 * tb) * DM + 32 * fb + 8 * g) = v;
                ss += v[0] * v[0] + v[1] * v[1] + v[2] * v[2] + v[3] * v[3];
                lds_put4(sreg + (32 * tb + r) * 144 + (32 * fb + 8 * g + 4 * h) * 2, v[0], v[1], v[2], v[3]);
            }
            ss = xhalf_sum(ss);
            if (h == 0) ssq[(size_t)(f0w >> 6) * T_TOK + tok0w + 32 * tb + r] = ss;
        }
        stage_flush<128, 128, false>(sreg, 32 * h + r, xb + (size_t)tok0w * DM + f0w, DM);
    }
};

struct EpiBf16 {
    bf16_t* out;
    static constexpr bool HAS_NSW = false, PERM_TOK = false, STAGED = true;
    DI void tile_prologue(char*, int, int) const {}
    DI bool swapped(int) const { return true; }
    DI void nsw(f32x16 (&)[2][4], int, int, int, int, char*, const char*) const {}
    DI void swp(f32x16 (&acc)[2][4], int tok0w, int f0w, int r, int h, char* sreg, const char* xtra) const {
#pragma unroll
        for (int tb = 0; tb < 4; ++tb)
#pragma unroll
            for (int fb = 0; fb < 2; ++fb)
#pragma unroll
                for (int g = 0; g < 4; ++g)
                    lds_put4(sreg + (32 * tb + r) * 144 + (32 * fb + 8 * g + 4 * h) * 2, acc[fb][tb][4 * g], acc[fb][tb][4 * g + 1], acc[fb][tb][4 * g + 2], acc[fb][tb][4 * g + 3]);
        stage_flush<128, 128, false>(sreg, 32 * h + r, out + (size_t)tok0w * DM + f0w, DM);
    }
};

struct EpiPle {
    float* x; bf16_t* pj; const float* ssq_in; float* ssq_out;
    static constexpr bool HAS_NSW = false, PERM_TOK = false, STAGED = true;
    DI void tile_prologue(char*, int, int) const {}
    DI bool swapped(int) const { return true; }
    DI void nsw(f32x16 (&)[2][4], int, int, int, int, char*, const char*) const {}
    DI void swp(f32x16 (&acc)[2][4], int tok0w, int f0w, int r, int h, char* sreg, const char* xtra) const {
        f32x4 rv[2][8]; u32x2 pw[2][8];
        const float* tbl = wave_rstd_table(ssq_in, tok0w, xtra, 32 * h + r);
        const size_t base = (size_t)(tok0w + r) * DM + f0w + 4 * h;
#pragma unroll
        for (int q = 0; q < 8; ++q) { const size_t o = base + 32 * (q >> 2) + 8 * (q & 3); rv[0][q] = *(const f32x4*)(x + o); pw[0][q] = *(const u32x2*)(pj + o); }
#pragma unroll
        for (int tb = 0; tb < 4; ++tb) {
            if (tb < 3) {
#pragma unroll
                for (int q = 0; q < 8; ++q) { const size_t o = base + (size_t)(32 * (tb + 1)) * DM + 32 * (q >> 2) + 8 * (q & 3); rv[(tb + 1) & 1][q] = *(const f32x4*)(x + o); pw[(tb + 1) & 1][q] = *(const u32x2*)(pj + o); }
            }
            const float rs = tbl[32 * tb + r];
            float ss = 0.f;
#pragma unroll
            for (int q = 0; q < 8; ++q) {
                const int fb = q >> 2, g = q & 3; const f32x4 c = rv[tb & 1][q]; const u32x2 w = pw[tb & 1][q];
                const float p0 = __uint_as_float(w.x << 16), p1 = __uint_as_float(w.x & 0xffff0000u), p2 = __uint_as_float(w.y << 16), p3 = __uint_as_float(w.y & 0xffff0000u);
                f32x4 v = {c[0] + sigmoidf_(acc[fb][tb][4 * g] * rs) * p0, c[1] + sigmoidf_(acc[fb][tb][4 * g + 1] * rs) * p1, c[2] + sigmoidf_(acc[fb][tb][4 * g + 2] * rs) * p2, c[3] + sigmoidf_(acc[fb][tb][4 * g + 3] * rs) * p3};
                *(f32x4*)(x + base + (size_t)(32 * tb) * DM + 32 * fb + 8 * g) = v;
                ss += v[0] * v[0] + v[1] * v[1] + v[2] * v[2] + v[3] * v[3];
                lds_put4(sreg + (32 * tb + r) * 144 + (32 * fb + 8 * g + 4 * h) * 2, v[0], v[1], v[2], v[3]);
            }
            ss = xhalf_sum(ss);
            if (h == 0) ssq_out[(size_t)(f0w >> 6) * T_TOK + tok0w + 32 * tb + r] = ss;
        }
        stage_flush<128, 128, false>(sreg, 32 * h + r, pj + (size_t)tok0w * DM + f0w, DM);
    }
};

DI float dpp_prev(float v) { return __builtin_bit_cast(float, __builtin_amdgcn_update_dpp(0, __builtin_bit_cast(int, v), 0x138, 0xf, 0xf, false)); }
DI float dpp_next(float v) { return __builtin_bit_cast(float, __builtin_amdgcn_update_dpp(0, __builtin_bit_cast(int, v), 0x130, 0xf, 0xf, false)); }
struct EpiUp {
    bf16_t* act; float* halo; const float* cw; const float* cb; const float* ssq;
    static constexpr bool HAS_NSW = false, PERM_TOK = true, STAGED = true;
    DI bool swapped(int) const { return true; }
    DI void tile_prologue(char* lds, int col0, int tid) const {
        float* pl = (float*)(lds + 4 * GT_BYTES);
        const int idx = tid * 2, p = idx >> 8, slot = idx & 255, pc = col0 + slot;
        const int ch = (pc >> 6) * 32 + (slot & 31) + ((slot >> 5) & 1) * DFF;
        const f32x2 v = p < 3 ? *(const f32x2*)(cw + p * 5632 + ch) : *(const f32x2*)(cb + ch);
        *(f32x2*)(pl + idx) = v;
    }
    DI void nsw(f32x16 (&)[2][4], int, int, int, int, char*, const char*) const {}
    DI void swp(f32x16 (&acc)[2][4], int tok0w, int f0w, int r, int h, char* sreg, const char* xtra) const {
        {
            const float* tbl = wave_rstd_table(ssq, tok0w, xtra, 32 * h + r);
            const f32x4 q = *(const f32x4*)(tbl + 4 * r);
#pragma unroll
            for (int tb = 0; tb < 4; ++tb) { const float rs = q[tb];
#pragma unroll
                for (int fb = 0; fb < 2; ++fb)
#pragma unroll
                    for (int i = 0; i < 16; ++i) acc[fb][tb][i] *= rs; }
        }
        const int c0 = (f0w >> 6) * 32;
        float* hl = halo + (size_t)(tok0w >> 7) * 4 * 5632;
        const float* pl = (const float*)xtra + (f0w & 255);
#pragma unroll
        for (int g = 0; g < 4; ++g) {
            const int c = c0 + 8 * g + 4 * h;
            f32x4 w0[2], w1[2], w2[2], bb[2];
#pragma unroll
            for (int fb = 0; fb < 2; ++fb) { const int sl = 32 * fb + 8 * g + 4 * h; w0[fb] = *(const f32x4*)(pl + sl); w1[fb] = *(const f32x4*)(pl + 256 + sl); w2[fb] = *(const f32x4*)(pl + 512 + sl); bb[fb] = *(const f32x4*)(pl + 768 + sl); }
            float o[4][4];
#pragma unroll
            for (int e = 0; e < 4; ++e) {
                float cv[2][4];
#pragma unroll
                for (int fb = 0; fb < 2; ++fb) {
                    const float u0 = acc[fb][0][4 * g + e], u1 = acc[fb][1][4 * g + e], u2 = acc[fb][2][4 * g + e], u3 = acc[fb][3][4 * g + e];
                    const float pv = dpp_prev(u3), nx = dpp_next(u0);
                    const float a0 = w0[fb][e], a1 = w1[fb][e], a2 = w2[fb][e], b0 = bb[fb][e];
                    cv[fb][0] = pv * a0 + (u0 * a1 + (u1 * a2 + b0));
                    cv[fb][1] = u0 * a0 + (u1 * a1 + (u2 * a2 + b0));
                    cv[fb][2] = u1 * a0 + (u2 * a1 + (u3 * a2 + b0));
                    cv[fb][3] = u2 * a0 + (u3 * a1 + (nx * a2 + b0));
                }
#pragma unroll
                for (int tb = 0; tb < 4; ++tb) o[tb][e] = cv[0][tb] * sigmoidf_(cv[0][tb]) * cv[1][tb];
            }
#pragma unroll
            for (int tb = 0; tb < 4; ++tb) lds_put4(sreg + (4 * r + tb) * 80 + (8 * g + 4 * h) * 2, o[tb][0], o[tb][1], o[tb][2], o[tb][3]);
            if (r == 0) {
#pragma unroll
                for (int fb = 0; fb < 2; ++fb)
#pragma unroll
                    for (int tb = 0; tb < 2; ++tb) *(f32x4*)(hl + (size_t)tb * 5632 + c + fb * DFF) = (f32x4){acc[fb][tb][4 * g], acc[fb][tb][4 * g + 1], acc[fb][tb][4 * g + 2], acc[fb][tb][4 * g + 3]};
            }
            if (r == 31) {
#pragma unroll
                for (int fb = 0; fb < 2; ++fb)
#pragma unroll
                    for (int tb = 2; tb < 4; ++tb) *(f32x4*)(hl + (size_t)tb * 5632 + c + fb * DFF) = (f32x4){acc[fb][tb][4 * g], acc[fb][tb][4 * g + 1], acc[fb][tb][4 * g + 2], acc[fb][tb][4 * g + 3]};
            }
        }
        stage_flush<128, 64, true>(sreg, 32 * h + r, act + (size_t)tok0w * DFF + c0, DFF);
    }
};

DI void phase_fix(const float* __restrict__ halo, bf16_t* __restrict__ act, const float* __restrict__ cw, const float* __restrict__ cb) {
    const int total = 256 * 2 * DFF;
    for (int i = blockIdx.x * NTHREADS + tidx(); i < total; i += gridDim.x * NTHREADS) {
        const int c = i % DFF, et = i / DFF, k = et >> 1, side = et & 1;
        const int t = k * 128 + (side ? 127 : 0); const int s = t & (SEQ - 1);
        const float* hk = halo + (size_t)k * 4 * 5632;
        float o[2];
#pragma unroll
        for (int fb = 0; fb < 2; ++fb) {
            const int ch = c + fb * DFF; float pv, cu, nx;
            if (side == 0) { cu = hk[ch]; nx = hk[5632 + ch]; pv = s == 0 ? 0.f : hk[ch - 5632]; }
            else { cu = hk[3 * 5632 + ch]; pv = hk[2 * 5632 + ch]; nx = s == SEQ - 1 ? 0.f : hk[4 * 5632 + ch]; }
            o[fb] = pv * cw[ch] + cu * cw[5632 + ch] + nx * cw[2 * 5632 + ch] + cb[ch];
        }
        const float a = o[0] * sigmoidf_(o[0]) * o[1];
        act[(size_t)t * DFF + c] = (bf16_t)(pk2(a, 0.f) & 0xffff);
    }
}

template <int NDB, bool NA>
DI void attn_tile(const char* ldsK, const char* ldsV, const bf16x8 (&qf)[4], f32x16 (&o)[NDB], float& m, float& l, int r, int h, const float* lbias, int qc, f32x16& sinit, bool first) {
    const int pr = (r & 0x13) | ((r & 4) << 1) | ((r & 8) >> 1);
    f32x16 s[2];
#pragma unroll
    for (int ks = 0; ks < 2; ++ks) {
        const char* kp = ldsK + (ks * 32 + pr) * LROW + h * 16;
        s[ks] = mfma32(*(const bf16x8*)kp, qf[0], sinit);
#pragma unroll
        for (int t = 1; t < 4; ++t) s[ks] = mfma32(*(const bf16x8*)(kp + t * 32), qf[t], s[ks]);
    }
    if (NA) {
        int cs = qc - 8; cs = cs < 0 ? 0 : (cs > 48 ? 48 : cs);
        int base = 8 * h - qc + 15, base2 = 8 * h - cs;
#pragma unroll
        for (int ks = 0; ks < 2; ++ks)
#pragma unroll
            for (int i = 0; i < 16; ++i) {
                const int off = 32 * ks + (i & 7) + 16 * (i >> 3);
                int d = base + off; d = d < 0 ? 0 : (d > 30 ? 30 : d);
                const bool valid = (unsigned)(base2 + off) < 16u;
                s[ks][i] = valid ? s[ks][i] + lbias[d] : -1e30f;
            }
    }
    float mx = fmaxf(s[0][0], s[0][1]);
#pragma unroll
    for (int i = 2; i < 16; i += 2) mx = fmaxf(mx, fmaxf(s[0][i], s[0][i + 1]));
#pragma unroll
    for (int i = 0; i < 16; i += 2) mx = fmaxf(mx, fmaxf(s[1][i], s[1][i + 1]));
    mx = xhalf_max(mx);
    if (first || __builtin_amdgcn_ballot_w64(mx > 8.0f) != 0ull) {
        const float dlt = first ? mx : fmaxf(mx, 0.f);
        const float alpha = first ? 1.0f : fexp2(-dlt);
        m += dlt; l *= alpha;
#pragma unroll
        for (int i = 0; i < 16; ++i) sinit[i] = -m;
#pragma unroll
        for (int ks = 0; ks < 2; ++ks)
#pragma unroll
            for (int i = 0; i < 16; ++i) s[ks][i] -= dlt;
#pragma unroll
        for (int db = 0; db < NDB; ++db)
#pragma unroll
            for (int i = 0; i < 16; ++i) o[db][i] *= alpha;
    }
    float ps0 = 0.f, ps1 = 0.f;
#pragma unroll
    for (int ks = 0; ks < 2; ++ks)
#pragma unroll
        for (int i = 0; i < 16; i += 2) { const float p0 = fexp2(s[ks][i]), p1 = fexp2(s[ks][i + 1]); ps0 += p0; ps1 += p1; s[ks][i] = p0; s[ks][i + 1] = p1; }
    l += ps0 + ps1;
#pragma unroll
    for (int ks = 0; ks < 2; ++ks)
#pragma unroll
        for (int sp = 0; sp < 2; ++sp) {
            u32x4 pw; pw.x = pk2(s[ks][8 * sp], s[ks][8 * sp + 1]); pw.y = pk2(s[ks][8 * sp + 2], s[ks][8 * sp + 3]); pw.z = pk2(s[ks][8 * sp + 4], s[ks][8 * sp + 5]); pw.w = pk2(s[ks][8 * sp + 6], s[ks][8 * sp + 7]);
            const bf16x8 pf = __builtin_bit_cast(bf16x8, pw);
            const char* vp = ldsV + r * LROW + (ks * 32 + sp * 16 + h * 8) * 2;
#pragma unroll
            for (int db = 0; db < NDB; ++db) o[db] = mfma32(*(const bf16x8*)(vp + db * 32 * LROW), pf, o[db]);
        }
}

constexpr int KT_BYTES = 64 * LROW;

DI void attn_gqa_unit(char* lds, const bf16_t* __restrict__ qkb, const bf16_t* __restrict__ bvt, bf16_t* __restrict__ mix, int u) {
    const int tid = tidx(), lane = tid & 63, wid = __builtin_amdgcn_readfirstlane(tid >> 6), r = lane & 31, h = lane >> 5;
    const int pair = u & 7, qb = u >> 3, b = pair >> 1, g = pair & 1;
    const int tq = b * SEQ + qb * 64 + (wid >> 2) * 32 + r;
    const int qhead = g * 4 + (wid & 3);
    bf16x8 qf[4];
#pragma unroll
    for (int t = 0; t < 4; ++t) qf[t] = *(const bf16x8*)(qkb + (size_t)tq * QLD + 1024 + qhead * 64 + 16 * t + 8 * h);
    f32x16 o[2];
#pragma unroll
    for (int db = 0; db < 2; ++db)
#pragma unroll
        for (int i = 0; i < 16; ++i) o[db][i] = 0.f;
    float m = 0.f, l = 0.f;
    f32x16 sinit;
#pragma unroll
    for (int i = 0; i < 16; ++i) sinit[i] = 0.f;
    const int lrow = tid >> 3, lkc = tid & 7, lw = lrow * LROW + lkc * 16;
    const bf16_t* gk = qkb + (size_t)(b * SEQ + lrow) * QLD + 1536 + g * 64 + lkc * 8;
    const bf16_t* gv = bvt + (size_t)((b * 2 + g) * 64 + lrow) * SEQ + lkc * 8;
    u32x4 rk = *(const u32x4*)gk, rv = *(const u32x4*)gv;
    *(u32x4*)(lds + lw) = rk; *(u32x4*)(lds + KT_BYTES + lw) = rv;
#pragma unroll
    for (int t = 0; t < 4; ++t) asm volatile("" : "+v"(qf[t]));
    __syncthreads();
    constexpr int NT = SEQ / 64;
#pragma unroll 1
    for (int it = 0; it < NT; ++it) {
        const bool more = it + 1 < NT;
        if (more) { rk = *(const u32x4*)(gk + (size_t)(it + 1) * 64 * QLD); rv = *(const u32x4*)(gv + (it + 1) * 64); }
        const char* buf = lds + (it & 1) * 2 * KT_BYTES;
        attn_tile<2, false>(buf, buf + KT_BYTES, qf, o, m, l, r, h, nullptr, 0, sinit, it == 0);
        if (more) { char* d = lds + ((it + 1) & 1) * 2 * KT_BYTES + lw; *(u32x4*)d = rk; *(u32x4*)(d + KT_BYTES) = rv; }
        __syncthreads();
    }
    l += __shfl_xor(l, 32);
    const float inv = 1.0f / l;
#pragma unroll
    for (int db = 0; db < 2; ++db)
#pragma unroll
        for (int g4 = 0; g4 < 4; ++g4)
            st_bf4(mix + (size_t)tq * DM + 512 + qhead * 64 + 32 * db + 8 * g4 + 4 * h, o[db][4 * g4] * inv, o[db][4 * g4 + 1] * inv, o[db][4 * g4 + 2] * inv, o[db][4 * g4 + 3] * inv);
}


DI void attn_gqa2_unit(char* lds, const bf16_t* __restrict__ qkb, const bf16_t* __restrict__ bvt, bf16_t* __restrict__ mix, int u) {
    const int tid = tidx(), lane = tid & 63, wid = __builtin_amdgcn_readfirstlane(tid >> 6), r = lane & 31, h = lane >> 5;
    const int pair = u & 7, qb = u >> 3, b = pair >> 1, g = pair & 1;
    const int tq0 = b * SEQ + qb * 128 + (wid >> 2) * 64 + r;
    const int qhead = g * 4 + (wid & 3);
    bf16x8 qf[2][4];
#pragma unroll
    for (int sb = 0; sb < 2; ++sb)
#pragma unroll
        for (int t = 0; t < 4; ++t) qf[sb][t] = *(const bf16x8*)(qkb + (size_t)(tq0 + 32 * sb) * QLD + 1024 + qhead * 64 + 16 * t + 8 * h);
    f32x16 o[2][2];
#pragma unroll
    for (int sb = 0; sb < 2; ++sb)
#pragma unroll
        for (int db = 0; db < 2; ++db)
#pragma unroll
            for (int i = 0; i < 16; ++i) o[sb][db][i] = 0.f;
    float m[2] = {-1e30f, -1e30f}, l[2] = {0.f, 0.f};
    const int lrow = tid >> 3, lkc = tid & 7, lw = lrow * LROW + lkc * 16;
    const bf16_t* gk = qkb + (size_t)(b * SEQ + lrow) * QLD + 1536 + g * 64 + lkc * 8;
    const bf16_t* gv = bvt + (size_t)((b * 2 + g) * 64 + lrow) * SEQ + lkc * 8;
    u32x4 rk = *(const u32x4*)gk, rv = *(const u32x4*)gv;
    *(u32x4*)(lds + lw) = rk; *(u32x4*)(lds + KT_BYTES + lw) = rv;
#pragma unroll
    for (int sb = 0; sb < 2; ++sb)
#pragma unroll
        for (int t = 0; t < 4; ++t) asm volatile("" : "+v"(qf[sb][t]));
    __syncthreads();
    const int pr = (r & 0x13) | ((r & 4) << 1) | ((r & 8) >> 1);
    constexpr int NT = SEQ / 64;
#pragma unroll 1
    for (int it = 0; it < NT; ++it) {
        const bool more = it + 1 < NT;
        if (more) { rk = *(const u32x4*)(gk + (size_t)(it + 1) * 64 * QLD); rv = *(const u32x4*)(gv + (it + 1) * 64); }
        const char* ldsK = lds + (it & 1) * 2 * KT_BYTES; const char* ldsV = ldsK + KT_BYTES;
        f32x16 s[2][2];
#pragma unroll
        for (int ks = 0; ks < 2; ++ks) {
            const char* kp = ldsK + (ks * 32 + pr) * LROW + h * 16;
#pragma unroll
            for (int sb = 0; sb < 2; ++sb)
#pragma unroll
                for (int i = 0; i < 16; ++i) s[sb][ks][i] = 0.f;
#pragma unroll
            for (int t = 0; t < 4; ++t) { const bf16x8 kf = *(const bf16x8*)(kp + t * 32); s[0][ks] = mfma32(kf, qf[0][t], s[0][ks]); s[1][ks] = mfma32(kf, qf[1][t], s[1][ks]); }
        }
        u32x4 pw[2][2][2];
#pragma unroll
        for (int sb = 0; sb < 2; ++sb) {
            float mx = fmaxf(s[sb][0][0], s[sb][0][1]);
#pragma unroll
            for (int i = 2; i < 16; i += 2) mx = fmaxf(mx, fmaxf(s[sb][0][i], s[sb][0][i + 1]));
#pragma unroll
            for (int i = 0; i < 16; i += 2) mx = fmaxf(mx, fmaxf(s[sb][1][i], s[sb][1][i + 1]));
            mx = xhalf_max(mx);
            if (__builtin_amdgcn_ballot_w64(mx > m[sb] + 8.0f) != 0ull) {
                const float mn = fmaxf(m[sb], mx), alpha = fexp2(m[sb] - mn);
                m[sb] = mn; l[sb] *= alpha;
#pragma unroll
                for (int db = 0; db < 2; ++db)
#pragma unroll
                    for (int i = 0; i < 16; ++i) o[sb][db][i] *= alpha;
            }
            float ps0 = 0.f, ps1 = 0.f;
#pragma unroll
            for (int ks = 0; ks < 2; ++ks)
#pragma unroll
                for (int i = 0; i < 16; i += 2) { const float p0 = fexp2(s[sb][ks][i] - m[sb]), p1 = fexp2(s[sb][ks][i + 1] - m[sb]); ps0 += p0; ps1 += p1; s[sb][ks][i] = p0; s[sb][ks][i + 1] = p1; }
            l[sb] += ps0 + ps1;
#pragma unroll
            for (int ks = 0; ks < 2; ++ks)
#pragma unroll
                for (int sp = 0; sp < 2; ++sp) {
                    pw[sb][ks][sp].x = pk2(s[sb][ks][8 * sp], s[sb][ks][8 * sp + 1]); pw[sb][ks][sp].y = pk2(s[sb][ks][8 * sp + 2], s[sb][ks][8 * sp + 3]);
                    pw[sb][ks][sp].z = pk2(s[sb][ks][8 * sp + 4], s[sb][ks][8 * sp + 5]); pw[sb][ks][sp].w = pk2(s[sb][ks][8 * sp + 6], s[sb][ks][8 * sp + 7]);
                }
        }
#pragma unroll
        for (int ks = 0; ks < 2; ++ks)
#pragma unroll
            for (int sp = 0; sp < 2; ++sp) {
                const char* vp = ldsV + r * LROW + (ks * 32 + sp * 16 + h * 8) * 2;
#pragma unroll
                for (int db = 0; db < 2; ++db) {
                    const bf16x8 vf = *(const bf16x8*)(vp + db * 32 * LROW);
                    o[0][db] = mfma32(vf, __builtin_bit_cast(bf16x8, pw[0][ks][sp]), o[0][db]);
                    o[1][db] = mfma32(vf, __builtin_bit_cast(bf16x8, pw[1][ks][sp]), o[1][db]);
                }
            }
        if (more) { char* d = lds + ((it + 1) & 1) * 2 * KT_BYTES + lw; *(u32x4*)d = rk; *(u32x4*)(d + KT_BYTES) = rv; }
        __syncthreads();
    }
#pragma unroll
    for (int sb = 0; sb < 2; ++sb) {
        const float lt = l[sb] + __shfl_xor(l[sb], 32);
        const float inv = 1.0f / lt;
#pragma unroll
        for (int db = 0; db < 2; ++db)
#pragma unroll
            for (int g4 = 0; g4 < 4; ++g4)
                st_bf4(mix + (size_t)(tq0 + 32 * sb) * DM + 512 + qhead * 64 + 32 * db + 8 * g4 + 4 * h, o[sb][db][4 * g4] * inv, o[sb][db][4 * g4 + 1] * inv, o[sb][db][4 * g4 + 2] * inv, o[sb][db][4 * g4 + 3] * inv);
    }
}

DI void attn_diff_unit(char* lds, const bf16_t* __restrict__ qkb, const bf16_t* __restrict__ avt, bf16_t* __restrict__ mix, int u, float lam, float lam_init, const float* __restrict__ subln) {
    const int tid = tidx(), lane = tid & 63, wid = __builtin_amdgcn_readfirstlane(tid >> 6), r = lane & 31, h = lane >> 5;
    const int pair = (u & 7) + 8 * (u >> 9), qb = ((u >> 3) & 31) + 32 * ((u >> 8) & 1), b = pair >> 2, hd = pair & 3;
    const int j = wid >> 2, qs = wid & 3;
    const int tq = b * SEQ + qb * 128 + qs * 32 + r;
    bf16x8 qf[4];
#pragma unroll
    for (int t = 0; t < 4; ++t) qf[t] = *(const bf16x8*)(qkb + (size_t)tq * QLD + (2 * hd + j) * 64 + 16 * t + 8 * h);
    f32x16 o[4];
#pragma unroll
    for (int db = 0; db < 4; ++db)
#pragma unroll
        for (int i = 0; i < 16; ++i) o[db][i] = 0.f;
    float m = 0.f, l = 0.f;
    f32x16 sinit;
#pragma unroll
    for (int i = 0; i < 16; ++i) sinit[i] = 0.f;
    const int lrow = tid >> 3, lkc = tid & 7, lw = lrow * LROW + lkc * 16;
    const bf16_t* gk = qkb + (size_t)(b * SEQ + lrow) * QLD + 512 + (2 * hd) * 64 + lkc * 8;
    const bf16_t* gv = avt + (size_t)((b * 4 + hd) * 128 + lrow) * SEQ + lkc * 8;
    constexpr int STG = 4 * KT_BYTES;
    u32x4 r0 = *(const u32x4*)gk, r1 = *(const u32x4*)(gk + 64), r2 = *(const u32x4*)gv, r3 = *(const u32x4*)(gv + (size_t)64 * SEQ);
    *(u32x4*)(lds + lw) = r0; *(u32x4*)(lds + KT_BYTES + lw) = r1; *(u32x4*)(lds + 2 * KT_BYTES + lw) = r2; *(u32x4*)(lds + 3 * KT_BYTES + lw) = r3;
#pragma unroll
    for (int t = 0; t < 4; ++t) asm volatile("" : "+v"(qf[t]));
    __syncthreads();
    constexpr int NT = SEQ / 64;
#pragma unroll 1
    for (int it = 0; it < NT; ++it) {
        const bool more = it + 1 < NT;
        if (more) { const bf16_t* k2 = gk + (size_t)(it + 1) * 64 * QLD; const bf16_t* v2 = gv + (it + 1) * 64; r0 = *(const u32x4*)k2; r1 = *(const u32x4*)(k2 + 64); r2 = *(const u32x4*)v2; r3 = *(const u32x4*)(v2 + (size_t)64 * SEQ); }
        const char* buf = lds + (it & 1) * STG;
        attn_tile<4, false>(buf + j * KT_BYTES, buf + 2 * KT_BYTES, qf, o, m, l, r, h, nullptr, 0, sinit, it == 0);
        if (more) { char* d = lds + ((it + 1) & 1) * STG + lw; *(u32x4*)d = r0; *(u32x4*)(d + KT_BYTES) = r1; *(u32x4*)(d + 2 * KT_BYTES) = r2; *(u32x4*)(d + 3 * KT_BYTES) = r3; }
        __syncthreads();
    }
    l += __shfl_xor(l, 32);
    const float inv = 1.0f / l;
    float* xch = (float*)lds;
    if (j == 1) {
#pragma unroll
        for (int db = 0; db < 4; ++db)
#pragma unroll
            for (int i = 0; i < 16; ++i) xch[((qs * 4 + db) * 16 + i) * 64 + lane] = o[db][i] * inv;
    }
    __syncthreads();
    if (j == 0) {
        float ss = 0.f;
#pragma unroll
        for (int db = 0; db < 4; ++db)
#pragma unroll
            for (int i = 0; i < 16; ++i) { const float v = o[db][i] * inv - lam * xch[((qs * 4 + db) * 16 + i) * 64 + lane]; o[db][i] = v; ss += v * v; }
        ss += __shfl_xor(ss, 32);
        const float rs = __builtin_amdgcn_rsqf(ss * (1.0f / 128.0f) + EPS) * (1.0f - lam_init);
#pragma unroll
        for (int db = 0; db < 4; ++db)
#pragma unroll
            for (int g4 = 0; g4 < 4; ++g4) {
                const int d = 32 * db + 8 * g4 + 4 * h; const f32x4 gv4 = *(const f32x4*)(subln + d);
                st_bf4(mix + (size_t)tq * DM + hd * 128 + d, o[db][4 * g4] * rs * gv4[0], o[db][4 * g4 + 1] * rs * gv4[1], o[db][4 * g4 + 2] * rs * gv4[2], o[db][4 * g4 + 3] * rs * gv4[3]);
            }
    }
    __syncthreads();
}

DI void attn_na_unit(char* lds, const bf16_t* __restrict__ qkb, const bf16_t* __restrict__ cvt, bf16_t* __restrict__ mix, int u, const float* __restrict__ bias) {
    const int tid = tidx(), lane = tid & 63, wid = __builtin_amdgcn_readfirstlane(tid >> 6), r = lane & 31, h = lane >> 5;
    const int hg = u & 3, R = (u >> 2) & 127, b = u >> 9;
    const int hw = wid & 3, head = 4 * hg + hw, qc = (wid >> 2) * 32 + r;
    const int tq = b * SEQ + R * 64 + qc;
    int rs = R - 4; rs = rs < 0 ? 0 : (rs > 120 ? 120 : rs);
    constexpr int STG = 8 * KT_BYTES;
    bf16x8 qf[4];
#pragma unroll
    for (int t = 0; t < 4; ++t) qf[t] = *(const bf16x8*)(qkb + (size_t)tq * QLD + head * 64 + 16 * t + 8 * h);
    f32x16 o[2];
#pragma unroll
    for (int db = 0; db < 2; ++db)
#pragma unroll
        for (int i = 0; i < 16; ++i) o[db][i] = 0.f;
    float m = 0.f, l = 0.f;
    f32x16 sinit;
#pragma unroll
    for (int i = 0; i < 16; ++i) sinit[i] = 0.f;
    const int lrow = tid >> 3, lkc = tid & 7, lw = lrow * LROW + lkc * 16;
    const bf16_t* gk = qkb + (size_t)(b * SEQ + rs * 64 + lrow) * QLD + 1024 + (4 * hg) * 64 + lkc * 8;
    const bf16_t* gv = cvt + (size_t)((b * 16 + 4 * hg) * 64 + lrow) * SEQ + rs * 64 + lkc * 8;
    float* lb = (float*)(lds + 4 * GT_BYTES);
    for (int i = tid; i < 4 * 465; i += NTHREADS) lb[i] = bias[(size_t)hg * 4 * 465 + i] * LOG2E;
    u32x4 rk[4], rv[4];
#pragma unroll
    for (int hd = 0; hd < 4; ++hd) { rk[hd] = *(const u32x4*)(gk + 64 * hd); rv[hd] = *(const u32x4*)(gv + (size_t)hd * 64 * SEQ); }
#pragma unroll
    for (int hd = 0; hd < 4; ++hd) { *(u32x4*)(lds + (2 * hd) * KT_BYTES + lw) = rk[hd]; *(u32x4*)(lds + (2 * hd + 1) * KT_BYTES + lw) = rv[hd]; }
#pragma unroll
    for (int t = 0; t < 4; ++t) asm volatile("" : "+v"(qf[t]));
    __syncthreads();
#pragma unroll 1
    for (int it = 0; it < 8; ++it) {
        const bool more = it + 1 < 8;
        if (more) {
#pragma unroll
            for (int hd = 0; hd < 4; ++hd) { rk[hd] = *(const u32x4*)(gk + (size_t)(it + 1) * 64 * QLD + 64 * hd); rv[hd] = *(const u32x4*)(gv + (size_t)hd * 64 * SEQ + (it + 1) * 64); }
        }
        const char* buf = lds + (it & 1) * STG + (2 * hw) * KT_BYTES;
        const float* brow = lb + (hw * 15 + (rs + it - R + 7)) * 31;
        attn_tile<2, true>(buf, buf + KT_BYTES, qf, o, m, l, r, h, brow, qc, sinit, it == 0);
        if (more) {
            char* d = lds + ((it + 1) & 1) * STG + lw;
#pragma unroll
            for (int hd = 0; hd < 4; ++hd) { *(u32x4*)(d + (2 * hd) * KT_BYTES) = rk[hd]; *(u32x4*)(d + (2 * hd + 1) * KT_BYTES) = rv[hd]; }
        }
        __syncthreads();
    }
    l += __shfl_xor(l, 32);
    const float inv = 1.0f / l;
#pragma unroll
    for (int db = 0; db < 2; ++db)
#pragma unroll
        for (int g4 = 0; g4 < 4; ++g4)
            st_bf4(mix + (size_t)tq * DM + head * 64 + 32 * db + 8 * g4 + 4 * h, o[db][4 * g4] * inv, o[db][4 * g4 + 1] * inv, o[db][4 * g4 + 2] * inv, o[db][4 * g4 + 3] * inv);
}


#define XB_TMO      128
#define XB_XCNT(j)  (256  + 64 * (j))
#define XB_XSUB(j)  (1280 + 64 * (j))
#define XB_XGEN(j)  (2304 + 64 * (j))
#define XB_TOP      3328
#define XB_TOPGEN   3392
#define XCD_BAR_WORDS 3456
#define XB_SPIN_CAP (1u << 23)
#define LAS __attribute__((address_space(3)))
DI unsigned xb_ld(unsigned* p)              { return __hip_atomic_load(p, __ATOMIC_RELAXED, __HIP_MEMORY_SCOPE_AGENT); }
DI unsigned xb_add(unsigned* p, unsigned v) { return __hip_atomic_fetch_add(p, v, __ATOMIC_RELAXED, __HIP_MEMORY_SCOPE_AGENT); }
DI unsigned xb_xcc_id() { return (unsigned)__builtin_amdgcn_s_getreg((3 << 11) | 20) & 0xFu; }
#define XB_SPIN(cond, bar) do { unsigned _sp = 0; while (cond) { __builtin_amdgcn_s_sleep(1); \
    if ((++_sp & 255u) == 0u) { if (xb_ld(&(bar)[XB_TMO])) break; if (_sp > XB_SPIN_CAP) { atomicAdd(&(bar)[XB_TMO], 1u); break; } } } } while (0)
struct XcdBarrier { unsigned* bar; unsigned x; volatile LAS unsigned* st; unsigned slot; };
DI XcdBarrier xcd_barrier_post(unsigned* bar, volatile LAS unsigned* st) {
    XcdBarrier b; b.bar = bar; b.x = xb_xcc_id(); b.st = st; b.slot = 0u;
    if (threadIdx.x == 0) b.slot = xb_add(&bar[XB_XCNT(b.x)], 1u);
    return b;
}
DI void xcd_barrier_complete(unsigned* bar, unsigned x, unsigned& nloc, unsigned& nx) {
    const unsigned G = gridDim.x * gridDim.y * gridDim.z;
    unsigned sum, cnt, mine, sp = 0u;
    for (;;) {
        sum = 0u; cnt = 0u; mine = 0u;
#pragma unroll
        for (unsigned j = 0; j < 16; ++j) { const unsigned c = xb_ld(&bar[XB_XCNT(j)]); sum += c; cnt += (c > 0u) ? 1u : 0u; mine = (j == x) ? c : mine; }
        if (sum == G) break;
        __builtin_amdgcn_s_sleep(1);
        if ((++sp & 255u) == 0u) { if (xb_ld(&bar[XB_TMO])) break; if (sp > XB_SPIN_CAP) { atomicAdd(&bar[XB_TMO], 1u); break; } }
    }
    nloc = mine > 0u ? mine : 1u; nx = cnt > 0u ? cnt : 1u;
}
DI void xcd_barrier(const XcdBarrier& b) {
    asm volatile("s_waitcnt vmcnt(0)" ::: "memory");
    __syncthreads();
    if (threadIdx.x == 0) {
        unsigned* bar = b.bar;
        __builtin_amdgcn_s_waitcnt(0);
        unsigned nloc = b.st[0], nx = b.st[1];
        if (nloc == 0u) { xcd_barrier_complete(bar, b.x, nloc, nx); b.st[0] = nloc; b.st[1] = nx; }
        const unsigned old = xb_add(&bar[XB_XSUB(b.x)], 1u);
        const unsigned gen = old / nloc;
        if (old + 1u == (gen + 1u) * nloc) {
            __builtin_amdgcn_fence(__ATOMIC_RELEASE, "agent");
            asm volatile("s_waitcnt vmcnt(0)" ::: "memory");
            const unsigned og = xb_add(&bar[XB_TOP], 1u);
            const unsigned tg = og / nx;
            if (og + 1u == (tg + 1u) * nx) xb_add(&bar[XB_TOPGEN], 1u);
            else XB_SPIN(xb_ld(&bar[XB_TOPGEN]) == tg, bar);
            __builtin_amdgcn_fence(__ATOMIC_ACQUIRE, "agent");
            xb_add(&bar[XB_XGEN(b.x)], 1u);
            asm volatile("s_waitcnt vmcnt(0)" ::: "memory");
        } else {
            XB_SPIN(xb_ld(&bar[XB_XGEN(b.x)]) == gen, bar);
            __builtin_amdgcn_fence(__ATOMIC_ACQUIRE, "agent");
            asm volatile("s_waitcnt vmcnt(0)" ::: "memory");
        }
    }
    __syncthreads();
}

__global__ void __launch_bounds__(NTHREADS) fwd_megakernel(Params P) {
    extern __shared__ __attribute__((aligned(16))) char lds[];
    cg::grid_group grid = cg::this_grid();
    volatile LAS unsigned* xst = (volatile LAS unsigned*)(lds + LDS_BYTES - 16);
    if (threadIdx.x == 0) { xst[0] = 0u; xst[1] = 0u; }
    __syncthreads();
    const XcdBarrier xb = xcd_barrier_post((unsigned*)(P.ws + OFF_BAR), xst);
    char* ws = P.ws;
    bf16_t* H = (bf16_t*)(ws + OFF_H); bf16_t* QKB = (bf16_t*)(ws + OFF_QKB); bf16_t* VT = (bf16_t*)(ws + OFF_VT);
    bf16_t* ACT = (bf16_t*)(ws + OFF_ACT); bf16_t* MIX = (bf16_t*)(ws + OFF_MIX); float* HALO = (float*)(ws + OFF_HALO); bf16_t* PB = (bf16_t*)(ws + OFF_PB);
    const f32x2* ROPEA = (const f32x2*)(ws + OFF_ROPEA); const f32x2* ROPEB = (const f32x2*)(ws + OFF_ROPEB);
    float* X = P.out;
    bf16_t* AVT = VT; bf16_t* BVT = VT + (size_t)4 * 4 * 128 * SEQ;

    float* SSQ = (float*)(ws + OFF_SSQ);
    phase_prep(P, lds);
    phase_x0(P.x, MIX, SSQ);
    phase_cvt_p(P.p, PB);
    grid.sync();
    int vbid = blockIdx.x;
    {
        volatile LAS unsigned* vst = (volatile LAS unsigned*)(lds + LDS_BYTES - 32);
        if (threadIdx.x == 0) {
            unsigned* bar = (unsigned*)(P.ws + OFF_BAR); bool ok = (gridDim.x & 7) == 0;
            for (unsigned jx = 0; jx < 16; ++jx) { const unsigned c = xb_ld(&bar[XB_XCNT(jx)]); ok = ok && (c == (jx < 8 ? gridDim.x / 8 : 0u)); }
            vst[0] = ok ? xb.slot * 8u + xb.x : blockIdx.x;
        }
        __syncthreads();
        vbid = (int)vst[0];
        __syncthreads();
    }

#pragma unroll 1
    for (int l = 0; l < 4; ++l) {
        const bf16_t* wl = (const bf16_t*)(ws + OFF_WB) + (size_t)l * WL_ELEMS; const int j = l >> 1;
        const float* xres = l == 0 ? P.x : X;
        float* ssq_a = SSQ + (size_t)(3 * l) * T_TOK * 16; float* ssq_f = ssq_a + (size_t)T_TOK * 16; float* ssq_p = ssq_f + (size_t)T_TOK * 16; float* ssq_n = ssq_p + (size_t)T_TOK * 16;
        if ((l & 1) == 0) {
            EpiInEven e{QKB, AVT, BVT, ROPEA, ROPEB, P.bq_norm + j * 64, P.bk_norm + j * 64, ssq_a};
            gemm_phase(lds, MIX, DM, wl + WL_WIN, 1024, 2304, e, vbid);
            xcd_barrier(xb);
            const float lam_init = j == 0 ? P.lam_init[0] : P.lam_init[1];
            float lam;
            { const int lane = threadIdx.x & 63; float a = P.lq1[j * 64 + lane] * P.lk1[j * 64 + lane], c = P.lq2[j * 64 + lane] * P.lk2[j * 64 + lane];
#pragma unroll
              for (int o = 32; o >= 1; o >>= 1) { a += __shfl_xor(a, o); c += __shfl_xor(c, o); }
              lam = __expf(a) - __expf(c) + lam_init; }
            for (int u = vbid; u < 1536; u += gridDim.x) {
                if (u < 1024) attn_diff_unit(lds, QKB, AVT, MIX, u, lam, lam_init, P.a_subln + j * 128);
                else attn_gqa2_unit(lds, QKB, BVT, MIX, u - 1024);
            }
            xcd_barrier(xb);
        } else {
            EpiInOdd e{QKB, VT, ssq_a};
            gemm_phase(lds, MIX, DM, wl + WL_WIN, 1024, 3072, e, vbid);
            xcd_barrier(xb);
            for (int u = vbid; u < 2048; u += gridDim.x) attn_na_unit(lds, QKB, VT, MIX, u, P.c_rel_bias + (size_t)j * 16 * 15 * 31);
            xcd_barrier(xb);
        }
        { EpiResid e{xres, X, H, ssq_f}; gemm_phase(lds, MIX, DM, wl + WL_WOUT, 1024, 1024, e, vbid); }
        xcd_barrier(xb);
        { EpiUp e{ACT, HALO, P.conv_w + (size_t)l * 3 * 5632, P.conv_b + (size_t)l * 5632, ssq_f}; gemm_phase(lds, H, DM, wl + WL_WUP, 1024, 5632, e, vbid); }
        { EpiBf16 e{MIX}; gemm_phase(lds, PB, PLE, wl + WL_WPROJ, 256, 1024, e, vbid); }
        xcd_barrier(xb);
        phase_fix(HALO, ACT, P.conv_w + (size_t)l * 3 * 5632, P.conv_b + (size_t)l * 5632);
        if (l < 3) phase_cvt_p(P.p + (size_t)(l + 1) * T_TOK * PLE, PB);
        xcd_barrier(xb);
        { EpiResid e{X, X, H, ssq_p}; gemm_phase(lds, ACT, DFF, wl + WL_WDOWN, 2816, 1024, e, vbid); }
        xcd_barrier(xb);
        { EpiPle e{X, MIX, ssq_p, ssq_n}; gemm_phase(lds, H, DM, wl + WL_WGATE, 1024, 1024, e, vbid); }
        xcd_barrier(xb);
    }
    phase_final_norm(X, P.final_norm);
}

extern "C" void kernel_launch(void* const* d_in, const int* in_sizes, int n_in, void* d_out, int out_size, void* d_ws, size_t ws_size, hipStream_t stream) {
    static int grid_blocks = 0;
    if (!grid_blocks) {
        int dev = 0, cus = 0, per_cu = 0;
        hipGetDevice(&dev);
        hipDeviceGetAttribute(&cus, hipDeviceAttributeMultiprocessorCount, dev);
        if (hipFuncSetAttribute((const void*)fwd_megakernel, hipFuncAttributeMaxDynamicSharedMemorySize, LDS_BYTES) != hipSuccess) fprintf(stderr, "hipFuncSetAttribute failed\n");
        hipOccupancyMaxActiveBlocksPerMultiprocessor(&per_cu, (const void*)fwd_megakernel, NTHREADS, LDS_BYTES);
        if (per_cu < 1) { fprintf(stderr, "occupancy query returned %d\n", per_cu); per_cu = 1; }
        grid_blocks = cus * 1;
    }
    if (ws_size < WS_NEEDED) { fprintf(stderr, "workspace too small: %zu < %zu\n", ws_size, (size_t)WS_NEEDED); return; }
    Params P{};
    const float* const* in = (const float* const*)d_in;
    P.x = in[0]; P.p = in[1]; P.attn_norm = in[2]; P.w_in_ab = in[3]; P.lq1 = in[4]; P.lk1 = in[5]; P.lq2 = in[6]; P.lk2 = in[7];
    P.a_subln = in[8]; P.bq_norm = in[9]; P.bk_norm = in[10]; P.w_out_ab = in[11]; P.w_in_c = in[12]; P.c_rel_bias = in[13]; P.w_out_c = in[14];
    P.ffn_norm = in[15]; P.w_ffn_up = in[16]; P.conv_w = in[17]; P.conv_b = in[18]; P.w_ffn_down = in[19]; P.ple_norm = in[20];
    P.w_ple_gate = in[21]; P.w_ple_proj = in[22]; P.final_norm = in[23];
    P.out = (float*)d_out; P.ws = (char*)d_ws;
    for (int i = 0; i < 8; ++i) P.inv_a[i] = powf(500000.0f, -(float)i / 8.0f);
    for (int i = 0; i < 16; ++i) P.inv_b[i] = powf(10000.0f, -(float)i / 16.0f);
    P.lam_init[0] = (float)(0.8 - 0.6 * exp(-0.3 * 0.0)); P.lam_init[1] = (float)(0.8 - 0.6 * exp(-0.3 * 2.0)); P.lam_init[2] = 0.f; P.lam_init[3] = 0.f;
    hipMemsetAsync((char*)d_ws + OFF_BAR, 0, 16384, stream);
    void* args[] = {&P};
    hipError_t e = hipLaunchCooperativeKernel((const void*)fwd_megakernel, dim3(grid_blocks), dim3(NTHREADS), args, LDS_BYTES, stream);
    if (e != hipSuccess) fprintf(stderr, "cooperative launch failed: %s (grid %d)\n", hipGetErrorString(e), grid_blocks);
}
```

```cpp
#include <hip/hip_runtime.h>
#include <hip/hip_cooperative_groups.h>
#include <cstdio>
#include <cmath>
#include <cstdint>
namespace cg = cooperative_groups;

typedef unsigned short bf16_t;
typedef short bf16x8 __attribute__((ext_vector_type(8)));
typedef float f32x16 __attribute__((ext_vector_type(16)));
typedef float f32x4 __attribute__((ext_vector_type(4)));
typedef float f32x2 __attribute__((ext_vector_type(2)));
typedef unsigned u32x4 __attribute__((ext_vector_type(4)));
typedef unsigned u32x2 __attribute__((ext_vector_type(2)));
typedef __bf16 bf16v2 __attribute__((ext_vector_type(2)));

#define DI __device__ __forceinline__

constexpr int T_TOK = 32768, SEQ = 8192, DM = 1024, DFF = 2816, PLE = 256;
constexpr float EPS = 1e-6f;
constexpr float QSCALE = 0.125f * 1.4426950408889634f;
constexpr float LOG2E = 1.4426950408889634f;
constexpr int NTHREADS = 512;
constexpr int LROW = 144;
constexpr int GT_BYTES = 256 * LROW;
constexpr int LDS_BYTES = 4 * GT_BYTES + 8192 + 512;

constexpr size_t MiB = 1024 * 1024;
constexpr size_t OFF_ROPEA = 0;
constexpr size_t OFF_ROPEB = 524288;
constexpr size_t OFF_BAR = 640 * 1024;
constexpr size_t OFF_WB = 1 * MiB;
constexpr size_t WL_WIN = 0, WL_WOUT = 3145728, WL_WUP = WL_WOUT + 1048576, WL_WDOWN = WL_WUP + 5767168,
                 WL_WGATE = WL_WDOWN + 2883584, WL_WPROJ = WL_WGATE + 1048576, WL_ELEMS = WL_WPROJ + 262144;
constexpr size_t OFF_H = OFF_WB + 108 * MiB;
constexpr size_t OFF_QKB = OFF_H + 64 * MiB;
constexpr size_t OFF_VT = OFF_QKB + 128 * MiB;
constexpr size_t OFF_ACT = OFF_QKB;
constexpr size_t OFF_MIX = OFF_VT + 64 * MiB;
constexpr size_t OFF_HALO = OFF_MIX + 64 * MiB;
constexpr size_t OFF_PB = OFF_HALO + 22 * MiB;
constexpr size_t OFF_SSQ = OFF_PB + 16 * MiB;
constexpr size_t WS_NEEDED = OFF_SSQ + 26 * MiB;
static_assert(WL_ELEMS * 2 * 4 <= 108 * MiB, "weights");
constexpr int QLD = 2048;
constexpr int SREG_BYTES = 18432;

struct Params {
    const float* x; const float* p; const float* attn_norm; const float* w_in_ab;
    const float* lq1; const float* lk1; const float* lq2; const float* lk2;
    const float* a_subln; const float* bq_norm; const float* bk_norm; const float* w_out_ab;
    const float* w_in_c; const float* c_rel_bias; const float* w_out_c; const float* ffn_norm;
    const float* w_ffn_up; const float* conv_w; const float* conv_b; const float* w_ffn_down;
    const float* ple_norm; const float* w_ple_gate; const float* w_ple_proj; const float* final_norm;
    float* out; char* ws;
    float inv_a[8]; float inv_b[16]; float lam_init[4];
};

DI unsigned pk2(float lo, float hi) { f32x2 v = {lo, hi}; return __builtin_bit_cast(unsigned, __builtin_convertvector(v, bf16v2)); }
DI float bf2f(bf16_t b) { return __uint_as_float(((unsigned)b) << 16); }
DI f32x16 mfma32(bf16x8 a, bf16x8 b, f32x16 c) { return __builtin_amdgcn_mfma_f32_32x32x16_bf16(a, b, c, 0, 0, 0); }
DI float fexp2(float x) { return __builtin_amdgcn_exp2f(x); }
DI float frcp(float x) { return __builtin_amdgcn_rcpf(x); }
DI float xhalf_max(float x) { return fmaxf(x, __shfl_xor(x, 32)); }
DI float xhalf_sum(float x) { return x + __shfl_xor(x, 32); }
DI float sigmoidf_(float x) { return frcp(1.0f + fexp2(-x * LOG2E)); }

DI int tidx() { int t = threadIdx.x; asm volatile("" : "+v"(t)); return t; }

template <bool PERM_UP>
DI void convert_weight(char* lds, const float* __restrict__ src, bf16_t* __restrict__ dst, int K, int N, const float* __restrict__ gain = nullptr) {
    float* tile = (float*)lds;
    const int tid = tidx();
    const int ntk = K / 64, ntn = N / 64, nt = ntk * ntn;
    for (int t = blockIdx.x; t < nt; t += gridDim.x) {
        const int k0 = (t / ntn) * 64, n0 = (t % ntn) * 64;
#pragma unroll
        for (int i = 0; i < 8; ++i) { const int idx = tid + NTHREADS * i, k = idx >> 6, n = idx & 63; tile[k * 65 + n] = src[(size_t)(k0 + k) * N + n0 + n] * (gain ? gain[k0 + k] : 1.0f); }
        __syncthreads();
#pragma unroll
        for (int i = 0; i < 4; ++i) {
            const int idx = tid + NTHREADS * i, n = idx >> 5, k2 = idx & 31;
            int nn = n0 + n;
            if (PERM_UP) { const int c = nn < DFF ? nn : nn - DFF; nn = (c >> 5) * 64 + (nn < DFF ? 0 : 32) + (c & 31); }
            *(unsigned*)(dst + (size_t)nn * K + k0 + 2 * k2) = pk2(tile[(2 * k2) * 65 + n], tile[(2 * k2 + 1) * 65 + n]);
        }
        __syncthreads();
    }
}

DI void sincos_acc(float angf, float& sn, float& cs) {
    const double x = (double)angf;
    const double k = __builtin_rint(x * 0.15915494309189535);
    double y = __builtin_fma(-k, 6.283185307179586, x); y = __builtin_fma(-k, 2.4492935982947064e-16, y);
    const double y2 = y * y;
    double ts = y, s = y, tc = 1.0, c = 1.0;
#pragma unroll 1
    for (int n = 1; n <= 14; ++n) {
        tc *= -y2 / (double)((2 * n - 1) * (2 * n)); c += tc;
        ts *= -y2 / (double)((2 * n) * (2 * n + 1)); s += ts;
    }
    sn = (float)s; cs = (float)c;
}

DI void phase_prep(const Params& P, char* lds) {
    bf16_t* wb = (bf16_t*)(P.ws + OFF_WB);
    for (int l = 0; l < 4; ++l) {
        bf16_t* wl = wb + (size_t)l * WL_ELEMS; const int j = l >> 1;
        if ((l & 1) == 0) { convert_weight<false>(lds, P.w_in_ab + (size_t)j * 1024 * 2304, wl + WL_WIN, 1024, 2304, P.attn_norm + l * DM); convert_weight<false>(lds, P.w_out_ab + (size_t)j * 1024 * 1024, wl + WL_WOUT, 1024, 1024); }
        else { convert_weight<false>(lds, P.w_in_c + (size_t)j * 1024 * 3072, wl + WL_WIN, 1024, 3072, P.attn_norm + l * DM); convert_weight<false>(lds, P.w_out_c + (size_t)j * 1024 * 1024, wl + WL_WOUT, 1024, 1024); }
        convert_weight<true>(lds, P.w_ffn_up + (size_t)l * 1024 * 5632, wl + WL_WUP, 1024, 5632, P.ffn_norm + l * DM);
        convert_weight<false>(lds, P.w_ffn_down + (size_t)l * 2816 * 1024, wl + WL_WDOWN, 2816, 1024);
        convert_weight<false>(lds, P.w_ple_gate + (size_t)l * 1024 * 1024, wl + WL_WGATE, 1024, 1024, P.ple_norm + l * DM);
        convert_weight<false>(lds, P.w_ple_proj + (size_t)l * 256 * 1024, wl + WL_WPROJ, 256, 1024);
    }
    f32x2* ra = (f32x2*)(P.ws + OFF_ROPEA); f32x2* rb = (f32x2*)(P.ws + OFF_ROPEB);
    for (int i = blockIdx.x * NTHREADS + tidx(); i < 8192 + 128; i += gridDim.x * NTHREADS) {
        float sn, cs;
        if (i < 8192) {
#pragma unroll
            for (int k = 0; k < 8; ++k) { const float ang = (float)i * P.inv_a[k]; sincos_acc(ang, sn, cs); ra[i * 8 + k] = (f32x2){cs, sn}; }
        } else {
            const int q = i - 8192;
#pragma unroll
            for (int k = 0; k < 16; ++k) { const float ang = (float)q * P.inv_b[k]; sincos_acc(ang, sn, cs); rb[q * 16 + k] = (f32x2){cs, sn}; }
        }
    }
}

DI void phase_x0(const float* __restrict__ src, bf16_t* __restrict__ dst, float* __restrict__ ssq) {
    const int lane = tidx() & 63, wv = blockIdx.x * 8 + (tidx() >> 6), nw = gridDim.x * 8;
    for (int row = wv; row < T_TOK; row += nw) {
        const float* sp = src + (size_t)row * DM; f32x4 v[4]; float ss = 0.f;
#pragma unroll
        for (int i = 0; i < 4; ++i) { v[i] = *(const f32x4*)(sp + (i * 64 + lane) * 4); ss += v[i][0] * v[i][0] + v[i][1] * v[i][1] + v[i][2] * v[i][2] + v[i][3] * v[i][3]; }
#pragma unroll
        for (int o = 32; o >= 1; o >>= 1) ss += __shfl_xor(ss, o);
#pragma unroll
        for (int i = 0; i < 4; ++i) { u32x2 w; w.x = pk2(v[i][0], v[i][1]); w.y = pk2(v[i][2], v[i][3]); *(u32x2*)(dst + (size_t)row * DM + (i * 64 + lane) * 4) = w; }
        if (lane < 16) ssq[(size_t)lane * T_TOK + row] = lane == 0 ? ss : 0.f;
    }
}
DI float rstd_of(float ssq) { return __builtin_amdgcn_rsqf(ssq * (1.0f / DM) + EPS); }
DI float* wave_rstd_table(const float* __restrict__ ssqp, int tok0w, const char* xtra, int lane) {
    float* tbl = (float*)(xtra + 4096) + (tidx() >> 6) * 128;
    {
        const float* p = ssqp + tok0w + 2 * lane;
        f32x2 a[16];
#pragma unroll
        for (int i = 0; i < 16; ++i) a[i] = *(const f32x2*)(p + (size_t)i * T_TOK);
        const f32x2 t = (((a[0] + a[1]) + (a[2] + a[3])) + ((a[4] + a[5]) + (a[6] + a[7]))) + (((a[8] + a[9]) + (a[10] + a[11])) + ((a[12] + a[13]) + (a[14] + a[15])));
        *(f32x2*)(tbl + 2 * lane) = (f32x2){rstd_of(t.x), rstd_of(t.y)};
    }
    return tbl;
}

DI void phase_norm(const float* __restrict__ src, const float* __restrict__ g, bf16_t* __restrict__ dst) {
    const int lane = tidx() & 63, wv = blockIdx.x * 8 + (tidx() >> 6), nw = gridDim.x * 8;
    f32x4 gv[4];
#pragma unroll
    for (int i = 0; i < 4; ++i) gv[i] = *(const f32x4*)(g + (i * 64 + lane) * 4);
    for (int row = wv; row < T_TOK; row += nw) {
        const float* s = src + (size_t)row * DM; f32x4 v[4]; float ss = 0.f;
#pragma unroll
        for (int i = 0; i < 4; ++i) { v[i] = *(const f32x4*)(s + (i * 64 + lane) * 4); ss += v[i][0] * v[i][0] + v[i][1] * v[i][1] + v[i][2] * v[i][2] + v[i][3] * v[i][3]; }
#pragma unroll
        for (int o = 32; o >= 1; o >>= 1) ss += __shfl_xor(ss, o);
        const float rs = __builtin_amdgcn_rsqf(ss * (1.0f / DM) + EPS);
#pragma unroll
        for (int i = 0; i < 4; ++i) { u32x2 w; w.x = pk2(v[i][0] * rs * gv[i][0], v[i][1] * rs * gv[i][1]); w.y = pk2(v[i][2] * rs * gv[i][2], v[i][3] * rs * gv[i][3]); *(u32x2*)(dst + (size_t)row * DM + (i * 64 + lane) * 4) = w; }
    }
}
DI void phase_final_norm(float* __restrict__ x, const float* __restrict__ g) {
    const int lane = tidx() & 63, wv = blockIdx.x * 8 + (tidx() >> 6), nw = gridDim.x * 8;
    f32x4 gv[4];
#pragma unroll
    for (int i = 0; i < 4; ++i) gv[i] = *(const f32x4*)(g + (i * 64 + lane) * 4);
    for (int row = wv; row < T_TOK; row += nw) {
        float* s = x + (size_t)row * DM; f32x4 v[4]; float ss = 0.f;
#pragma unroll
        for (int i = 0; i < 4; ++i) { v[i] = *(const f32x4*)(s + (i * 64 + lane) * 4); ss += v[i][0] * v[i][0] + v[i][1] * v[i][1] + v[i][2] * v[i][2] + v[i][3] * v[i][3]; }
#pragma unroll
        for (int o = 32; o >= 1; o >>= 1) ss += __shfl_xor(ss, o);
        const float rs = __builtin_amdgcn_rsqf(ss * (1.0f / DM) + EPS);
#pragma unroll
        for (int i = 0; i < 4; ++i) *(f32x4*)(s + (i * 64 + lane) * 4) = v[i] * rs * gv[i];
    }
}
DI void phase_cvt_p(const float* __restrict__ src, bf16_t* __restrict__ dst) {
    const size_t n4 = (size_t)T_TOK * PLE / 4;
    for (size_t i = (size_t)blockIdx.x * NTHREADS + tidx(); i < n4; i += (size_t)gridDim.x * NTHREADS) {
        const f32x4 v = *(const f32x4*)(src + i * 4); u32x2 w; w.x = pk2(v[0], v[1]); w.y = pk2(v[2], v[3]); *(u32x2*)(dst + i * 4) = w;
    }
}

template <class Epi, bool SWP>
DI void gemm_tile(char* lds, const bf16_t* __restrict__ A, int lda, const bf16_t* __restrict__ Bt, int K, int tok0, int col0, const Epi& epi) {
    const int tid = tidx(), lane = tid & 63, wid = __builtin_amdgcn_readfirstlane(tid >> 6), wm = wid & 1, wn = wid >> 1, r = lane & 31, h = lane >> 5;
    const int lrow = tid >> 3, lkc = tid & 7;
    const bf16_t* ga = A + (size_t)(tok0 + lrow) * lda + lkc * 8;
    const bf16_t* gb = Bt + (size_t)(col0 + lrow) * K + lkc * 8;
    const int lw = lrow * LROW + lkc * 16;
    int lwa[4];
#pragma unroll
    for (int i = 0; i < 4; ++i) {
        if (Epi::PERM_TOK) { const int gr = lrow + 64 * i, tau = gr & 127; lwa[i] = ((gr & 128) + (tau & 3) * 32 + (tau >> 2)) * LROW + lkc * 16; }
        else lwa[i] = lw + 64 * i * LROW;
    }
    u32x4 ra[4], rb[4];
#pragma unroll
    for (int i = 0; i < 4; ++i) { ra[i] = *(const u32x4*)(ga + (size_t)(64 * i) * lda); rb[i] = *(const u32x4*)(gb + (size_t)(64 * i) * K); }
    epi.tile_prologue(lds, col0, tid);
    f32x16 acc[2][4];
#pragma unroll
    for (int a = 0; a < 2; ++a)
#pragma unroll
        for (int b = 0; b < 4; ++b)
#pragma unroll
            for (int i = 0; i < 16; ++i) acc[a][b][i] = 0.f;
#pragma unroll
    for (int i = 0; i < 4; ++i) { *(u32x4*)(lds + lwa[i]) = ra[i]; *(u32x4*)(lds + GT_BYTES + lw + 64 * i * LROW) = rb[i]; }
    __syncthreads();
    const int nk = K / 64;
    if (nk > 1) {
#pragma unroll
        for (int i = 0; i < 4; ++i) { ra[i] = *(const u32x4*)(ga + (size_t)(64 * i) * lda + 64); rb[i] = *(const u32x4*)(gb + (size_t)(64 * i) * K + 64); }
    }
#pragma unroll 1
    for (int kt = 0; kt < nk; ++kt) {
        const bool more = kt + 1 < nk, more2 = kt + 2 < nk;
        const char* sa = lds + (kt & 1) * 2 * GT_BYTES + (wm * 128 + r) * LROW + h * 16;
        const char* sb = lds + (kt & 1) * 2 * GT_BYTES + GT_BYTES + (wn * 64 + r) * LROW + h * 16;
        bf16x8 wf[2][2], xf[2][4];
#pragma unroll
        for (int fb = 0; fb < 2; ++fb) wf[0][fb] = *(const bf16x8*)(sb + fb * 32 * LROW);
#pragma unroll
        for (int tb = 0; tb < 4; ++tb) xf[0][tb] = *(const bf16x8*)(sa + tb * 32 * LROW);
#pragma unroll
        for (int t = 0; t < 4; ++t) {
            if (t < 3) {
#pragma unroll
                for (int fb = 0; fb < 2; ++fb) wf[(t + 1) & 1][fb] = *(const bf16x8*)(sb + fb * 32 * LROW + (t + 1) * 32);
#pragma unroll
                for (int tb = 0; tb < 4; ++tb) xf[(t + 1) & 1][tb] = *(const bf16x8*)(sa + tb * 32 * LROW + (t + 1) * 32);
            }
            if (t == 3 && more) {
                char* d = lds + ((kt + 1) & 1) * 2 * GT_BYTES;
#pragma unroll
                for (int i = 0; i < 4; ++i) { *(u32x4*)(d + lwa[i]) = ra[i]; *(u32x4*)(d + GT_BYTES + lw + 64 * i * LROW) = rb[i]; }
                if (more2) {
#pragma unroll
                    for (int i = 0; i < 4; ++i) { ra[i] = *(const u32x4*)(ga + (size_t)(64 * i) * lda + (kt + 2) * 64); rb[i] = *(const u32x4*)(gb + (size_t)(64 * i) * K + (kt + 2) * 64); }
                }
                __builtin_amdgcn_sched_barrier(0);
            }
#pragma unroll
            for (int fb = 0; fb < 2; ++fb)
#pragma unroll
                for (int tb = 0; tb < 4; ++tb) acc[fb][tb] = SWP ? mfma32(wf[t & 1][fb], xf[t & 1][tb], acc[fb][tb]) : mfma32(xf[t & 1][tb], wf[t & 1][fb], acc[fb][tb]);
            __builtin_amdgcn_sched_barrier(0);
        }
        __syncthreads();
    }
    char* sreg = lds + wid * SREG_BYTES;
    if (SWP) epi.swp(acc, tok0 + wm * 128, col0 + wn * 64, r, h, sreg, lds + 4 * GT_BYTES); else epi.nsw(acc, tok0 + wm * 128, col0 + wn * 64, r, h, sreg, lds + 4 * GT_BYTES);
    if (Epi::STAGED) __syncthreads();
}

template <class Epi>
DI void gemm_phase(char* lds, const bf16_t* A, int lda, const bf16_t* Bt, int K, int N, const Epi& epi, int vbid) {
    const int nN = N / 256;
    const int wn = __builtin_amdgcn_readfirstlane(tidx() >> 7);
    const int G = gridDim.x, bid = vbid;
    if ((G & 7) == 0) {
        const int x = bid & 7, per = G >> 3, nq = 16 * nN;
        for (int q = bid >> 3; q < nq; q += per) {
            const int tok0 = (16 * x + (q & 7) + 8 * (q / (8 * nN))) * 256, col0 = ((q >> 3) % nN) * 256;
            if (!Epi::HAS_NSW || epi.swapped(col0 + wn * 64)) gemm_tile<Epi, true>(lds, A, lda, Bt, K, tok0, col0, epi);
            else gemm_tile<Epi, false>(lds, A, lda, Bt, K, tok0, col0, epi);
        }
    } else {
        const int nU = (T_TOK / 256) * nN;
        for (int u = bid; u < nU; u += G) {
            const int tok0 = (u / nN) * 256, col0 = (u % nN) * 256;
            if (!Epi::HAS_NSW || epi.swapped(col0 + wn * 64)) gemm_tile<Epi, true>(lds, A, lda, Bt, K, tok0, col0, epi);
            else gemm_tile<Epi, false>(lds, A, lda, Bt, K, tok0, col0, epi);
        }
    }
}

DI void st_bf4(bf16_t* p, float a, float b, float c, float d) { u32x2 w; w.x = pk2(a, b); w.y = pk2(c, d); *(u32x2*)p = w; }
DI void lds_put4(char* p, float a, float b, float c, float d) { u32x2 w; w.x = pk2(a, b); w.y = pk2(c, d); *(u32x2*)p = w; }
template <int NROWS, int ROWB, bool SKIP_EDGES>
DI void stage_flush(const char* sreg, int lane, bf16_t* gbase, size_t gstride) {
    constexpr int CPR = ROWB / 16, TOTAL = NROWS * CPR;
    static_assert(NROWS * (ROWB + 16) <= SREG_BYTES, "staging region");
#pragma unroll
    for (int i = 0; i < TOTAL / 64; ++i) {
        const int idx = lane + 64 * i, row = idx / CPR, ch = idx % CPR;
        const u32x4 v = *(const u32x4*)(sreg + row * (ROWB + 16) + ch * 16);
        if (!SKIP_EDGES || (row != 0 && row != NROWS - 1)) *(u32x4*)(gbase + (size_t)row * gstride + ch * 8) = v;
    }
}

struct EpiInEven {
    bf16_t* qkb; bf16_t* avt; bf16_t* bvt; const f32x2* ropea; const f32x2* ropeb; const float* qn; const float* kn; const float* ssq;
    static constexpr bool HAS_NSW = true, PERM_TOK = false, STAGED = true;
    DI void tile_prologue(char*, int, int) const {}
    DI bool swapped(int f0) const { return !((f0 >= 1024 && f0 < 1536) || f0 >= 2176); }
    DI void nsw(f32x16 (&acc)[2][4], int tok0w, int f0w, int r, int h, char* sreg, const char* xtra) const {
        {
            const float* tbl = wave_rstd_table(ssq, tok0w, xtra, 32 * h + r);
#pragma unroll
            for (int tb = 0; tb < 4; ++tb)
#pragma unroll
                for (int g = 0; g < 4; ++g) { const f32x4 q = *(const f32x4*)(tbl + 32 * tb + 8 * g + 4 * h);
#pragma unroll
                    for (int e = 0; e < 4; ++e) { acc[0][tb][4 * g + e] *= q[e]; acc[1][tb][4 * g + e] *= q[e]; } }
        }
        {
            bf16_t* base; int drow0;
            if (f0w < 1536) { const int c = f0w - 1024; base = avt; drow0 = ((tok0w >> 13) * 4 + (c >> 7)) * 128 + (c & 127); }
            else { const int c = f0w - 2176; base = bvt; drow0 = ((tok0w >> 13) * 2 + (c >> 6)) * 64; }
            const int s0 = tok0w & (SEQ - 1);
#pragma unroll
            for (int fb = 0; fb < 2; ++fb)
#pragma unroll
                for (int tb = 0; tb < 4; ++tb)
#pragma unroll
                    for (int g = 0; g < 4; ++g)
                        lds_put4(sreg + (32 * fb + r) * 272 + (32 * tb + 8 * g + 4 * h) * 2, acc[fb][tb][4 * g], acc[fb][tb][4 * g + 1], acc[fb][tb][4 * g + 2], acc[fb][tb][4 * g + 3]);
            stage_flush<64, 256, false>(sreg, 32 * h + r, base + (size_t)drow0 * SEQ + s0, SEQ);
        }
    }
    DI void swp(f32x16 (&acc)[2][4], int tok0w, int f0w, int r, int h, char* sreg, const char* xtra) const {
        {
            const float* tbl = wave_rstd_table(ssq, tok0w, xtra, 32 * h + r);
#pragma unroll
            for (int tb = 0; tb < 4; ++tb) { const float rs = tbl[32 * tb + r];
#pragma unroll
                for (int fb = 0; fb < 2; ++fb)
#pragma unroll
                    for (int i = 0; i < 16; ++i) acc[fb][tb][i] *= rs; }
        }
        if (f0w < 1024) {
            const float sc = f0w < 512 ? QSCALE : 1.0f;
#pragma unroll
            for (int tb = 0; tb < 4; ++tb) {
                const int t = tok0w + 32 * tb + r, s = t & (SEQ - 1);
                const f32x4 cs0 = *(const f32x4*)(ropea + s * 8 + 4 * h), cs1 = *(const f32x4*)(ropea + s * 8 + 4 * h + 2);
                const float c[4] = {cs0[0], cs0[2], cs1[0], cs1[2]}, sn[4] = {cs0[1], cs0[3], cs1[1], cs1[3]};
#pragma unroll
                for (int e = 0; e < 4; ++e) { const float x1 = acc[0][tb][e], x2 = acc[0][tb][4 + e]; acc[0][tb][e] = x1 * c[e] - x2 * sn[e]; acc[0][tb][4 + e] = x2 * c[e] + x1 * sn[e]; }
#pragma unroll
                for (int fb = 0; fb < 2; ++fb)
#pragma unroll
                    for (int g = 0; g < 4; ++g)
                        lds_put4(sreg + (32 * tb + r) * 144 + (32 * fb + 8 * g + 4 * h) * 2, acc[fb][tb][4 * g] * sc, acc[fb][tb][4 * g + 1] * sc, acc[fb][tb][4 * g + 2] * sc, acc[fb][tb][4 * g + 3] * sc);
            }
            stage_flush<128, 128, false>(sreg, 32 * h + r, qkb + (size_t)tok0w * QLD + f0w, QLD);
            return;
        }
        const bool isq = f0w < 2048; const float sc = isq ? QSCALE : 1.0f; const float* gn = isq ? qn : kn;
        const int ocol = isq ? (1024 + f0w - 1536) : (1536 + f0w - 2048);
        f32x4 gv[2][4];
#pragma unroll
        for (int fb = 0; fb < 2; ++fb)
#pragma unroll
            for (int g = 0; g < 4; ++g) gv[fb][g] = *(const f32x4*)(gn + 32 * fb + 8 * g + 4 * h);
#pragma unroll
        for (int tb = 0; tb < 4; ++tb) {
            const int t = tok0w + 32 * tb + r, s = t & (SEQ - 1);
            float ss = 0.f;
#pragma unroll
            for (int fb = 0; fb < 2; ++fb)
#pragma unroll
                for (int i = 0; i < 16; ++i) ss += acc[fb][tb][i] * acc[fb][tb][i];
            ss += __shfl_xor(ss, 32);
            const float rs = __builtin_amdgcn_rsqf(ss * (1.0f / 64.0f) + EPS);
#pragma unroll
            for (int fb = 0; fb < 2; ++fb)
#pragma unroll
                for (int g = 0; g < 4; ++g)
#pragma unroll
                    for (int e = 0; e < 4; ++e) acc[fb][tb][4 * g + e] *= rs * gv[fb][g][e];
#pragma unroll
            for (int fb = 0; fb < 2; ++fb) {
                const int pos = fb == 0 ? (s >> 6) : (s & 63);
#pragma unroll
                for (int g = 0; g < 2; ++g) {
                    const f32x4 cs0 = *(const f32x4*)(ropeb + pos * 16 + 8 * g + 4 * h), cs1 = *(const f32x4*)(ropeb + pos * 16 + 8 * g + 4 * h + 2);
                    const float c[4] = {cs0[0], cs0[2], cs1[0], cs1[2]}, sn[4] = {cs0[1], cs0[3], cs1[1], cs1[3]};
#pragma unroll
                    for (int e = 0; e < 4; ++e) { const float x1 = acc[fb][tb][4 * g + e], x2 = acc[fb][tb][4 * (g + 2) + e]; acc[fb][tb][4 * g + e] = x1 * c[e] - x2 * sn[e]; acc[fb][tb][4 * (g + 2) + e] = x2 * c[e] + x1 * sn[e]; }
                }
            }
#pragma unroll
            for (int fb = 0; fb < 2; ++fb)
#pragma unroll
                for (int g = 0; g < 4; ++g)
                    lds_put4(sreg + (32 * tb + r) * 144 + (32 * fb + 8 * g + 4 * h) * 2, acc[fb][tb][4 * g] * sc, acc[fb][tb][4 * g + 1] * sc, acc[fb][tb][4 * g + 2] * sc, acc[fb][tb][4 * g + 3] * sc);
        }
        stage_flush<128, 128, false>(sreg, 32 * h + r, qkb + (size_t)tok0w * QLD + ocol, QLD);
    }
};

struct EpiInOdd {
    bf16_t* qkb; bf16_t* cvt; const float* ssq;
    static constexpr bool HAS_NSW = true, PERM_TOK = false, STAGED = true;
    DI void tile_prologue(char*, int, int) const {}
    DI bool swapped(int f0) const { return f0 < 2048; }
    DI void nsw(f32x16 (&acc)[2][4], int tok0w, int f0w, int r, int h, char* sreg, const char* xtra) const {
        {
            const float* tbl = wave_rstd_table(ssq, tok0w, xtra, 32 * h + r);
#pragma unroll
            for (int tb = 0; tb < 4; ++tb)
#pragma unroll
                for (int g = 0; g < 4; ++g) { const f32x4 q = *(const f32x4*)(tbl + 32 * tb + 8 * g + 4 * h);
#pragma unroll
                    for (int e = 0; e < 4; ++e) { acc[0][tb][4 * g + e] *= q[e]; acc[1][tb][4 * g + e] *= q[e]; } }
        }
        {
            const int c = f0w - 2048; const int drow0 = ((tok0w >> 13) * 16 + (c >> 6)) * 64; const int s0 = tok0w & (SEQ - 1);
#pragma unroll
            for (int fb = 0; fb < 2; ++fb)
#pragma unroll
                for (int tb = 0; tb < 4; ++tb)
#pragma unroll
                    for (int g = 0; g < 4; ++g)
                        lds_put4(sreg + (32 * fb + r) * 272 + (32 * tb + 8 * g + 4 * h) * 2, acc[fb][tb][4 * g], acc[fb][tb][4 * g + 1], acc[fb][tb][4 * g + 2], acc[fb][tb][4 * g + 3]);
            stage_flush<64, 256, false>(sreg, 32 * h + r, cvt + (size_t)drow0 * SEQ + s0, SEQ);
        }
    }
    DI void swp(f32x16 (&acc)[2][4], int tok0w, int f0w, int r, int h, char* sreg, const char* xtra) const {
        {
            const float* tbl = wave_rstd_table(ssq, tok0w, xtra, 32 * h + r);
#pragma unroll
            for (int tb = 0; tb < 4; ++tb) { const float rs = tbl[32 * tb + r];
#pragma unroll
                for (int fb = 0; fb < 2; ++fb)
#pragma unroll
                    for (int i = 0; i < 16; ++i) acc[fb][tb][i] *= rs; }
        }
        const float sc = f0w < 1024 ? QSCALE : 1.0f;
#pragma unroll
        for (int tb = 0; tb < 4; ++tb) {
            const int t = tok0w + 32 * tb + r;
#pragma unroll
            for (int fb = 0; fb < 2; ++fb)
#pragma unroll
                for (int g = 0; g < 4; ++g)
                    lds_put4(sreg + (32 * tb + r) * 144 + (32 * fb + 8 * g + 4 * h) * 2, acc[fb][tb][4 * g] * sc, acc[fb][tb][4 * g + 1] * sc, acc[fb][tb][4 * g + 2] * sc, acc[fb][tb][4 * g + 3] * sc);
        }
        stage_flush<128, 128, false>(sreg, 32 * h + r, qkb + (size_t)tok0w * QLD + f0w, QLD);
    }
};

struct EpiResid {
    const float* res; float* out; bf16_t* xb; float* ssq;
    static constexpr bool HAS_NSW = false, PERM_TOK = false, STAGED = true;
    DI void tile_prologue(char*, int, int) const {}
    DI bool swapped(int) const { return true; }
    DI void nsw(f32x16 (&)[2][4], int, int, int, int, char*, const char*) const {}
    DI void swp(f32x16 (&acc)[2][4], int tok0w, int f0w, int r, int h, char* sreg, const char* xtra) const {
        f32x4 rv[2][8];
        const size_t base = (size_t)(tok0w + r) * DM + f0w + 4 * h;
#pragma unroll
        for (int q = 0; q < 8; ++q) rv[0][q] = *(const f32x4*)(res + base + 32 * (q >> 2) + 8 * (q & 3));
#pragma unroll
        for (int tb = 0; tb < 4; ++tb) {
            if (tb < 3) {
#pragma unroll
                for (int q = 0; q < 8; ++q) rv[(tb + 1) & 1][q] = *(const f32x4*)(res + base + (size_t)(32 * (tb + 1)) * DM + 32 * (q >> 2) + 8 * (q & 3));
            }
            float ss = 0.f;
#pragma unroll
            for (int q = 0; q < 8; ++q) {
                const int fb = q >> 2, g = q & 3; const f32x4 c = rv[tb & 1][q];
                f32x4 v = {acc[fb][tb][4 * g] + c[0], acc[fb][tb][4 * g + 1] + c[1], acc[fb][tb][4 * g + 2] + c[2], acc[fb][tb][4 * g + 3] + c[3]};
                *(f32x4*)(out + base + (size_t)(32 * tb) * DM + 32 * fb + 8 * g) = v;
                ss += v[0] * v[0] + v[1] * v[1] + v[2] * v[2] + v[3] * v[3];
                lds_put4(sreg + (32 * tb + r) * 144 + (32 * fb + 8 * g + 4 * h) * 2, v[0], v[1], v[2], v[3]);
            }
            ss = xhalf_sum(ss);
            if (h == 0) ssq[(size_t)(f0w >> 6) * T_TOK + tok0w + 32 * tb + r] = ss;
        }
        stage_flush<128, 128, false>(sreg, 32 * h + r, xb + (size_t)tok0w * DM + f0w, DM);
    }
};

struct EpiBf16 {
    bf16_t* out;
    static constexpr bool HAS_NSW = false, PERM_TOK = false, STAGED = true;
    DI void tile_prologue(char*, int, int) const {}
    DI bool swapped(int) const { return true; }
    DI void nsw(f32x16 (&)[2][4], int, int, int, int, char*, const char*) const {}
    DI void swp(f32x16 (&acc)[2][4], int tok0w, int f0w, int r, int h, char* sreg, const char* xtra) const {
#pragma unroll
        for (int tb = 0; tb < 4; ++tb)
#pragma unroll
            for (int fb = 0; fb < 2; ++fb)
#pragma unroll
                for (int g = 0; g < 4; ++g)
                    lds_put4(sreg + (32 * tb + r) * 144 + (32 * fb + 8 * g + 4 * h) * 2, acc[fb][tb][4 * g], acc[fb][tb][4 * g + 1], acc[fb][tb][4 * g + 2], acc[fb][tb][4 * g + 3]);
        stage_flush<128, 128, false>(sreg, 32 * h + r, out + (size_t)tok0w * DM + f0w, DM);
    }
};

struct EpiPle {
    float* x; bf16_t* pj; const float* ssq_in; float* ssq_out;
    static constexpr bool HAS_NSW = false, PERM_TOK = false, STAGED = true;
    DI void tile_prologue(char*, int, int) const {}
    DI bool swapped(int) const { return true; }
    DI void nsw(f32x16 (&)[2][4], int, int, int, int, char*, const char*) const {}
    DI void swp(f32x16 (&acc)[2][4], int tok0w, int f0w, int r, int h, char* sreg, const char* xtra) const {
        f32x4 rv[2][8]; u32x2 pw[2][8];
        const float* tbl = wave_rstd_table(ssq_in, tok0w, xtra, 32 * h + r);
        const size_t base = (size_t)(tok0w + r) * DM + f0w + 4 * h;
#pragma unroll
        for (int q = 0; q < 8; ++q) { const size_t o = base + 32 * (q >> 2) + 8 * (q & 3); rv[0][q] = *(const f32x4*)(x + o); pw[0][q] = *(const u32x2*)(pj + o); }
#pragma unroll
        for (int tb = 0; tb < 4; ++tb) {
            if (tb < 3) {
#pragma unroll
                for (int q = 0; q < 8; ++q) { const size_t o = base + (size_t)(32 * (tb + 1)) * DM + 32 * (q >> 2) + 8 * (q & 3); rv[(tb + 1) & 1][q] = *(const f32x4*)(x + o); pw[(tb + 1) & 1][q] = *(const u32x2*)(pj + o); }
            }
            const float rs = tbl[32 * tb + r];
            float ss = 0.f;
#pragma unroll
            for (int q = 0; q < 8; ++q) {
                const int fb = q >> 2, g = q & 3; const f32x4 c = rv[tb & 1][q]; const u32x2 w = pw[tb & 1][q];
                const float p0 = __uint_as_float(w.x << 16), p1 = __uint_as_float(w.x & 0xffff0000u), p2 = __uint_as_float(w.y << 16), p3 = __uint_as_float(w.y & 0xffff0000u);
                f32x4 v = {c[0] + sigmoidf_(acc[fb][tb][4 * g] * rs) * p0, c[1] + sigmoidf_(acc[fb][tb][4 * g + 1] * rs) * p1, c[2] + sigmoidf_(acc[fb][tb][4 * g + 2] * rs) * p2, c[3] + sigmoidf_(acc[fb][tb][4 * g + 3] * rs) * p3};
                *(f32x4*)(x + base + (size_t)(32 * tb) * DM + 32 * fb + 8 * g) = v;
                ss += v[0] * v[0] + v[1] * v[1] + v[2] * v[2] + v[3] * v[3];
                lds_put4(sreg + (32 * tb + r) * 144 + (32 * fb + 8 * g + 4 * h) * 2, v[0], v[1], v[2], v[3]);
            }
            ss = xhalf_sum(ss);
            if (h == 0) ssq_out[(size_t)(f0w >> 6) * T_TOK + tok0w + 32 * tb + r] = ss;
        }
        stage_flush<128, 128, false>(sreg, 32 * h + r, pj + (size_t)tok0w * DM + f0w, DM);
    }
};

DI float dpp_prev(float v) { return __builtin_bit_cast(float, __builtin_amdgcn_update_dpp(0, __builtin_bit_cast(int, v), 0x138, 0xf, 0xf, false)); }
DI float dpp_next(float v) { return __builtin_bit_cast(float, __builtin_amdgcn_update_dpp(0, __builtin_bit_cast(int, v), 0x130, 0xf, 0xf, false)); }
struct EpiUp {
    bf16_t* act; float* halo; const float* cw; const float* cb; const float* ssq;
    static constexpr bool HAS_NSW = false, PERM_TOK = true, STAGED = true;
    DI bool swapped(int) const { return true; }
    DI void tile_prologue(char* lds, int col0, int tid) const {
        float* pl = (float*)(lds + 4 * GT_BYTES);
        const int idx = tid * 2, p = idx >> 8, slot = idx & 255, pc = col0 + slot;
        const int ch = (pc >> 6) * 32 + (slot & 31) + ((slot >> 5) & 1) * DFF;
        const f32x2 v = p < 3 ? *(const f32x2*)(cw + p * 5632 + ch) : *(const f32x2*)(cb + ch);
        *(f32x2*)(pl + idx) = v;
    }
    DI void nsw(f32x16 (&)[2][4], int, int, int, int, char*, const char*) const {}
    DI void swp(f32x16 (&acc)[2][4], int tok0w, int f0w, int r, int h, char* sreg, const char* xtra) const {
        {
            const float* tbl = wave_rstd_table(ssq, tok0w, xtra, 32 * h + r);
            const f32x4 q = *(const f32x4*)(tbl + 4 * r);
#pragma unroll
            for (int tb = 0; tb < 4; ++tb) { const float rs = q[tb];
#pragma unroll
                for (int fb = 0; fb < 2; ++fb)
#pragma unroll
                    for (int i = 0; i < 16; ++i) acc[fb][tb][i] *= rs; }
        }
        const int c0 = (f0w >> 6) * 32;
        float* hl = halo + (size_t)(tok0w >> 7) * 4 * 5632;
        const float* pl = (const float*)xtra + (f0w & 255);
#pragma unroll
        for (int g = 0; g < 4; ++g) {
            const int c = c0 + 8 * g + 4 * h;
            f32x4 w0[2], w1[2], w2[2], bb[2];
#pragma unroll
            for (int fb = 0; fb < 2; ++fb) { const int sl = 32 * fb + 8 * g + 4 * h; w0[fb] = *(const f32x4*)(pl + sl); w1[fb] = *(const f32x4*)(pl + 256 + sl); w2[fb] = *(const f32x4*)(pl + 512 + sl); bb[fb] = *(const f32x4*)(pl + 768 + sl); }
            float o[4][4];
#pragma unroll
            for (int e = 0; e < 4; ++e) {
                float cv[2][4];
#pragma unroll
                for (int fb = 0; fb < 2; ++fb) {
                    const float u0 = acc[fb][0][4 * g + e], u1 = acc[fb][1][4 * g + e], u2 = acc[fb][2][4 * g + e], u3 = acc[fb][3][4 * g + e];
                    const float pv = dpp_prev(u3), nx = dpp_next(u0);
                    const float a0 = w0[fb][e], a1 = w1[fb][e], a2 = w2[fb][e], b0 = bb[fb][e];
                    cv[fb][0] = pv * a0 + (u0 * a1 + (u1 * a2 + b0));
                    cv[fb][1] = u0 * a0 + (u1 * a1 + (u2 * a2 + b0));
                    cv[fb][2] = u1 * a0 + (u2 * a1 + (u3 * a2 + b0));
                    cv[fb][3] = u2 * a0 + (u3 * a1 + (nx * a2 + b0));
                }
#pragma unroll
                for (int tb = 0; tb < 4; ++tb) o[tb][e] = cv[0][tb] * sigmoidf_(cv[0][tb]) * cv[1][tb];
            }
#pragma unroll
            for (int tb = 0; tb < 4; ++tb) lds_put4(sreg + (4 * r + tb) * 80 + (8 * g + 4 * h) * 2, o[tb][0], o[tb][1], o[tb][2], o[tb][3]);
            if (r == 0) {
#pragma unroll
                for (int fb = 0; fb < 2; ++fb)
#pragma unroll
                    for (int tb = 0; tb < 2; ++tb) *(f32x4*)(hl + (size_t)tb * 5632 + c + fb * DFF) = (f32x4){acc[fb][tb][4 * g], acc[fb][tb][4 * g + 1], acc[fb][tb][4 * g + 2], acc[fb][tb][4 * g + 3]};
            }
            if (r == 31) {
#pragma unroll
                for (int fb = 0; fb < 2; ++fb)
#pragma unroll
                    for (int tb = 2; tb < 4; ++tb) *(f32x4*)(hl + (size_t)tb * 5632 + c + fb * DFF) = (f32x4){acc[fb][tb][4 * g], acc[fb][tb][4 * g + 1], acc[fb][tb][4 * g + 2], acc[fb][tb][4 * g + 3]};
            }
        }
        stage_flush<128, 64, true>(sreg, 32 * h + r, act + (size_t)tok0w * DFF + c0, DFF);
    }
};

DI void phase_fix(const float* __restrict__ halo, bf16_t* __restrict__ act, const float* __restrict__ cw, const float* __restrict__ cb) {
    const int total = 256 * 2 * DFF;
    for (int i = blockIdx.x * NTHREADS + tidx(); i < total; i += gridDim.x * NTHREADS) {
        const int c = i % DFF, et = i / DFF, k = et >> 1, side = et & 1;
        const int t = k * 128 + (side ? 127 : 0); const int s = t & (SEQ - 1);
        const float* hk = halo + (size_t)k * 4 * 5632;
        float o[2];
#pragma unroll
        for (int fb = 0; fb < 2; ++fb) {
            const int ch = c + fb * DFF; float pv, cu, nx;
            if (side == 0) { cu = hk[ch]; nx = hk[5632 + ch]; pv = s == 0 ? 0.f : hk[ch - 5632]; }
            else { cu = hk[3 * 5632 + ch]; pv = hk[2 * 5632 + ch]; nx = s == SEQ - 1 ? 0.f : hk[4 * 5632 + ch]; }
            o[fb] = pv * cw[ch] + cu * cw[5632 + ch] + nx * cw[2 * 5632 + ch] + cb[ch];
        }
        const float a = o[0] * sigmoidf_(o[0]) * o[1];
        act[(size_t)t * DFF + c] = (bf16_t)(pk2(a, 0.f) & 0xffff);
    }
}

template <int NDB, bool NA>
DI void attn_tile(const char* ldsK, const char* ldsV, const bf16x8 (&qf)[4], f32x16 (&o)[NDB], float& m, float& l, int r, int h, const float* lbias, int qc, f32x16& sinit, bool first) {
    const int pr = (r & 0x13) | ((r & 4) << 1) | ((r & 8) >> 1);
    f32x16 s[2];
#pragma unroll
    for (int ks = 0; ks < 2; ++ks) {
        const char* kp = ldsK + (ks * 32 + pr) * LROW + h * 16;
        s[ks] = mfma32(*(const bf16x8*)kp, qf[0], sinit);
#pragma unroll
        for (int t = 1; t < 4; ++t) s[ks] = mfma32(*(const bf16x8*)(kp + t * 32), qf[t], s[ks]);
    }
    if (NA) {
        int cs = qc - 8; cs = cs < 0 ? 0 : (cs > 48 ? 48 : cs);
        int base = 8 * h - qc + 15, base2 = 8 * h - cs;
#pragma unroll
        for (int ks = 0; ks < 2; ++ks)
#pragma unroll
            for (int i = 0; i < 16; ++i) {
                const int off = 32 * ks + (i & 7) + 16 * (i >> 3);
                int d = base + off; d = d < 0 ? 0 : (d > 30 ? 30 : d);
                const bool valid = (unsigned)(base2 + off) < 16u;
                s[ks][i] = valid ? s[ks][i] + lbias[d] : -1e30f;
            }
    }
    float mx = fmaxf(s[0][0], s[0][1]);
#pragma unroll
    for (int i = 2; i < 16; i += 2) mx = fmaxf(mx, fmaxf(s[0][i], s[0][i + 1]));
#pragma unroll
    for (int i = 0; i < 16; i += 2) mx = fmaxf(mx, fmaxf(s[1][i], s[1][i + 1]));
    mx = xhalf_max(mx);
    if (first || __builtin_amdgcn_ballot_w64(mx > 8.0f) != 0ull) {
        const float dlt = first ? mx : fmaxf(mx, 0.f);
        const float alpha = first ? 1.0f : fexp2(-dlt);
        m += dlt; l *= alpha;
#pragma unroll
        for (int i = 0; i < 16; ++i) sinit[i] = -m;
#pragma unroll
        for (int ks = 0; ks < 2; ++ks)
#pragma unroll
            for (int i = 0; i < 16; ++i) s[ks][i] -= dlt;
#pragma unroll
        for (int db = 0; db < NDB; ++db)
#pragma unroll
            for (int i = 0; i < 16; ++i) o[db][i] *= alpha;
    }
    float ps0 = 0.f, ps1 = 0.f;
#pragma unroll
    for (int ks = 0; ks < 2; ++ks)
#pragma unroll
        for (int i = 0; i < 16; i += 2) { const float p0 = fexp2(s[ks][i]), p1 = fexp2(s[ks][i + 1]); ps0 += p0; ps1 += p1; s[ks][i] = p0; s[ks][i + 1] = p1; }
    l += ps0 + ps1;
#pragma unroll
    for (int ks = 0; ks < 2; ++ks)
#pragma unroll
        for (int sp = 0; sp < 2; ++sp) {
            u32x4 pw; pw.x = pk2(s[ks][8 * sp], s[ks][8 * sp + 1]); pw.y = pk2(s[ks][8 * sp + 2], s[ks][8 * sp + 3]); pw.z = pk2(s[ks][8 * sp + 4], s[ks][8 * sp + 5]); pw.w = pk2(s[ks][8 * sp + 6], s[ks][8 * sp + 7]);
            const bf16x8 pf = __builtin_bit_cast(bf16x8, pw);
            const char* vp = ldsV + r * LROW + (ks * 32 + sp * 16 + h * 8) * 2;
#pragma unroll
            for (int db = 0; db < NDB; ++db) o[db] = mfma32(*(const bf16x8*)(vp + db * 32 * LROW), pf, o[db]);
        }
}

constexpr int KT_BYTES = 64 * LROW;

DI void attn_gqa_unit(char* lds, const bf16_t* __restrict__ qkb, const bf16_t* __restrict__ bvt, bf16_t* __restrict__ mix, int u) {
    const int tid = tidx(), lane = tid & 63, wid = __builtin_amdgcn_readfirstlane(tid >> 6), r = lane & 31, h = lane >> 5;
    const int pair = u & 7, qb = u >> 3, b = pair >> 1, g = pair & 1;
    const int tq = b * SEQ + qb * 64 + (wid >> 2) * 32 + r;
    const int qhead = g * 4 + (wid & 3);
    bf16x8 qf[4];
#pragma unroll
    for (int t = 0; t < 4; ++t) qf[t] = *(const bf16x8*)(qkb + (size_t)tq * QLD + 1024 + qhead * 64 + 16 * t + 8 * h);
    f32x16 o[2];
#pragma unroll
    for (int db = 0; db < 2; ++db)
#pragma unroll
        for (int i = 0; i < 16; ++i) o[db][i] = 0.f;
    float m = 0.f, l = 0.f;
    f32x16 sinit;
#pragma unroll
    for (int i = 0; i < 16; ++i) sinit[i] = 0.f;
    const int lrow = tid >> 3, lkc = tid & 7, lw = lrow * LROW + lkc * 16;
    const bf16_t* gk = qkb + (size_t)(b * SEQ + lrow) * QLD + 1536 + g * 64 + lkc * 8;
    const bf16_t* gv = bvt + (size_t)((b * 2 + g) * 64 + lrow) * SEQ + lkc * 8;
    u32x4 rk = *(const u32x4*)gk, rv = *(const u32x4*)gv;
    *(u32x4*)(lds + lw) = rk; *(u32x4*)(lds + KT_BYTES + lw) = rv;
#pragma unroll
    for (int t = 0; t < 4; ++t) asm volatile("" : "+v"(qf[t]));
    __syncthreads();
    constexpr int NT = SEQ / 64;
#pragma unroll 1
    for (int it = 0; it < NT; ++it) {
        const bool more = it + 1 < NT;
        if (more) { rk = *(const u32x4*)(gk + (size_t)(it + 1) * 64 * QLD); rv = *(const u32x4*)(gv + (it + 1) * 64); }
        const char* buf = lds + (it & 1) * 2 * KT_BYTES;
        attn_tile<2, false>(buf, buf + KT_BYTES, qf, o, m, l, r, h, nullptr, 0, sinit, it == 0);
        if (more) { char* d = lds + ((it + 1) & 1) * 2 * KT_BYTES + lw; *(u32x4*)d = rk; *(u32x4*)(d + KT_BYTES) = rv; }
        __syncthreads();
    }
    l += __shfl_xor(l, 32);
    const float inv = 1.0f / l;
#pragma unroll
    for (int db = 0; db < 2; ++db)
#pragma unroll
        for (int g4 = 0; g4 < 4; ++g4)
            st_bf4(mix + (size_t)tq * DM + 512 + qhead * 64 + 32 * db + 8 * g4 + 4 * h, o[db][4 * g4] * inv, o[db][4 * g4 + 1] * inv, o[db][4 * g4 + 2] * inv, o[db][4 * g4 + 3] * inv);
}


DI void attn_gqa2_unit(char* lds, const bf16_t* __restrict__ qkb, const bf16_t* __restrict__ bvt, bf16_t* __restrict__ mix, int u) {
    const int tid = tidx(), lane = tid & 63, wid = __builtin_amdgcn_readfirstlane(tid >> 6), r = lane & 31, h = lane >> 5;
    const int pair = u & 7, qb = u >> 3, b = pair >> 1, g = pair & 1;
    const int tq0 = b * SEQ + qb * 128 + (wid >> 2) * 64 + r;
    const int qhead = g * 4 + (wid & 3);
    bf16x8 qf[2][4];
#pragma unroll
    for (int sb = 0; sb < 2; ++sb)
#pragma unroll
        for (int t = 0; t < 4; ++t) qf[sb][t] = *(const bf16x8*)(qkb + (size_t)(tq0 + 32 * sb) * QLD + 1024 + qhead * 64 + 16 * t + 8 * h);
    f32x16 o[2][2];
#pragma unroll
    for (int sb = 0; sb < 2; ++sb)
#pragma unroll
        for (int db = 0; db < 2; ++db)
#pragma unroll
            for (int i = 0; i < 16; ++i) o[sb][db][i] = 0.f;
    float m[2] = {0.f, 0.f}, l[2] = {0.f, 0.f};
    f32x16 sinit[2];
#pragma unroll
    for (int sb = 0; sb < 2; ++sb)
#pragma unroll
        for (int i = 0; i < 16; ++i) sinit[sb][i] = 0.f;
    const int lrow = tid >> 3, lkc = tid & 7, lw = lrow * LROW + lkc * 16;
    const bf16_t* gk = qkb + (size_t)(b * SEQ + lrow) * QLD + 1536 + g * 64 + lkc * 8;
    const bf16_t* gv = bvt + (size_t)((b * 2 + g) * 64 + lrow) * SEQ + lkc * 8;
    u32x4 rk = *(const u32x4*)gk, rv = *(const u32x4*)gv;
    *(u32x4*)(lds + lw) = rk; *(u32x4*)(lds + KT_BYTES + lw) = rv;
#pragma unroll
    for (int sb = 0; sb < 2; ++sb)
#pragma unroll
        for (int t = 0; t < 4; ++t) asm volatile("" : "+v"(qf[sb][t]));
    __syncthreads();
    const int pr = (r & 0x13) | ((r & 4) << 1) | ((r & 8) >> 1);
    constexpr int NT = SEQ / 64;
#pragma unroll 1
    for (int it = 0; it < NT; ++it) {
        const bool more = it + 1 < NT;
        if (more) { rk = *(const u32x4*)(gk + (size_t)(it + 1) * 64 * QLD); rv = *(const u32x4*)(gv + (it + 1) * 64); }
        const char* ldsK = lds + (it & 1) * 2 * KT_BYTES; const char* ldsV = ldsK + KT_BYTES;
        f32x16 s[2][2];
#pragma unroll
        for (int ks = 0; ks < 2; ++ks) {
            const char* kp = ldsK + (ks * 32 + pr) * LROW + h * 16;
            { const bf16x8 kf = *(const bf16x8*)kp; s[0][ks] = mfma32(kf, qf[0][0], sinit[0]); s[1][ks] = mfma32(kf, qf[1][0], sinit[1]); }
#pragma unroll
            for (int t = 1; t < 4; ++t) { const bf16x8 kf = *(const bf16x8*)(kp + t * 32); s[0][ks] = mfma32(kf, qf[0][t], s[0][ks]); s[1][ks] = mfma32(kf, qf[1][t], s[1][ks]); }
        }
        u32x4 pw[2][2][2];
#pragma unroll
        for (int sb = 0; sb < 2; ++sb) {
            float mx = fmaxf(s[sb][0][0], s[sb][0][1]);
#pragma unroll
            for (int i = 2; i < 16; i += 2) mx = fmaxf(mx, fmaxf(s[sb][0][i], s[sb][0][i + 1]));
#pragma unroll
            for (int i = 0; i < 16; i += 2) mx = fmaxf(mx, fmaxf(s[sb][1][i], s[sb][1][i + 1]));
            mx = xhalf_max(mx);
            if (it == 0 || __builtin_amdgcn_ballot_w64(mx > 8.0f) != 0ull) {
                const float dlt = it == 0 ? mx : fmaxf(mx, 0.f);
                const float alpha = it == 0 ? 1.0f : fexp2(-dlt);
                m[sb] += dlt; l[sb] *= alpha;
#pragma unroll
                for (int i = 0; i < 16; ++i) sinit[sb][i] = -m[sb];
#pragma unroll
                for (int ks = 0; ks < 2; ++ks)
#pragma unroll
                    for (int i = 0; i < 16; ++i) s[sb][ks][i] -= dlt;
#pragma unroll
                for (int db = 0; db < 2; ++db)
#pragma unroll
                    for (int i = 0; i < 16; ++i) o[sb][db][i] *= alpha;
            }
            float ps0 = 0.f, ps1 = 0.f;
#pragma unroll
            for (int ks = 0; ks < 2; ++ks)
#pragma unroll
                for (int i = 0; i < 16; i += 2) { const float p0 = fexp2(s[sb][ks][i]), p1 = fexp2(s[sb][ks][i + 1]); ps0 += p0; ps1 += p1; s[sb][ks][i] = p0; s[sb][ks][i + 1] = p1; }
            l[sb] += ps0 + ps1;
#pragma unroll
            for (int ks = 0; ks < 2; ++ks)
#pragma unroll
                for (int sp = 0; sp < 2; ++sp) {
                    pw[sb][ks][sp].x = pk2(s[sb][ks][8 * sp], s[sb][ks][8 * sp + 1]); pw[sb][ks][sp].y = pk2(s[sb][ks][8 * sp + 2], s[sb][ks][8 * sp + 3]);
                    pw[sb][ks][sp].z = pk2(s[sb][ks][8 * sp + 4], s[sb][ks][8 * sp + 5]); pw[sb][ks][sp].w = pk2(s[sb][ks][8 * sp + 6], s[sb][ks][8 * sp + 7]);
                }
        }
#pragma unroll
        for (int ks = 0; ks < 2; ++ks)
#pragma unroll
            for (int sp = 0; sp < 2; ++sp) {
                const char* vp = ldsV + r * LROW + (ks * 32 + sp * 16 + h * 8) * 2;
#pragma unroll
                for (int db = 0; db < 2; ++db) {
                    const bf16x8 vf = *(const bf16x8*)(vp + db * 32 * LROW);
                    o[0][db] = mfma32(vf, __builtin_bit_cast(bf16x8, pw[0][ks][sp]), o[0][db]);
                    o[1][db] = mfma32(vf, __builtin_bit_cast(bf16x8, pw[1][ks][sp]), o[1][db]);
                }
            }
        if (more) { char* d = lds + ((it + 1) & 1) * 2 * KT_BYTES + lw; *(u32x4*)d = rk; *(u32x4*)(d + KT_BYTES) = rv; }
        __syncthreads();
    }
#pragma unroll
    for (int sb = 0; sb < 2; ++sb) {
        const float lt = l[sb] + __shfl_xor(l[sb], 32);
        const float inv = 1.0f / lt;
#pragma unroll
        for (int db = 0; db < 2; ++db)
#pragma unroll
            for (int g4 = 0; g4 < 4; ++g4)
                st_bf4(mix + (size_t)(tq0 + 32 * sb) * DM + 512 + qhead * 64 + 32 * db + 8 * g4 + 4 * h, o[sb][db][4 * g4] * inv, o[sb][db][4 * g4 + 1] * inv, o[sb][db][4 * g4 + 2] * inv, o[sb][db][4 * g4 + 3] * inv);
    }
}

DI void attn_diff_unit(char* lds, const bf16_t* __restrict__ qkb, const bf16_t* __restrict__ avt, bf16_t* __restrict__ mix, int u, float lam, float lam_init, const float* __restrict__ subln) {
    const int tid = tidx(), lane = tid & 63, wid = __builtin_amdgcn_readfirstlane(tid >> 6), r = lane & 31, h = lane >> 5;
    const int pair = (u & 7) + 8 * (u >> 9), qb = ((u >> 3) & 31) + 32 * ((u >> 8) & 1), b = pair >> 2, hd = pair & 3;
    const int j = wid >> 2, qs = wid & 3;
    const int tq = b * SEQ + qb * 128 + qs * 32 + r;
    bf16x8 qf[4];
#pragma unroll
    for (int t = 0; t < 4; ++t) qf[t] = *(const bf16x8*)(qkb + (size_t)tq * QLD + (2 * hd + j) * 64 + 16 * t + 8 * h);
    f32x16 o[4];
#pragma unroll
    for (int db = 0; db < 4; ++db)
#pragma unroll
        for (int i = 0; i < 16; ++i) o[db][i] = 0.f;
    float m = 0.f, l = 0.f;
    f32x16 sinit;
#pragma unroll
    for (int i = 0; i < 16; ++i) sinit[i] = 0.f;
    const int lrow = tid >> 3, lkc = tid & 7, lw = lrow * LROW + lkc * 16;
    const bf16_t* gk = qkb + (size_t)(b * SEQ + lrow) * QLD + 512 + (2 * hd) * 64 + lkc * 8;
    const bf16_t* gv = avt + (size_t)((b * 4 + hd) * 128 + lrow) * SEQ + lkc * 8;
    constexpr int STG = 4 * KT_BYTES;
    u32x4 r0 = *(const u32x4*)gk, r1 = *(const u32x4*)(gk + 64), r2 = *(const u32x4*)gv, r3 = *(const u32x4*)(gv + (size_t)64 * SEQ);
    *(u32x4*)(lds + lw) = r0; *(u32x4*)(lds + KT_BYTES + lw) = r1; *(u32x4*)(lds + 2 * KT_BYTES + lw) = r2; *(u32x4*)(lds + 3 * KT_BYTES + lw) = r3;
#pragma unroll
    for (int t = 0; t < 4; ++t) asm volatile("" : "+v"(qf[t]));
    __syncthreads();
    constexpr int NT = SEQ / 64;
#pragma unroll 1
    for (int it = 0; it < NT; ++it) {
        const bool more = it + 1 < NT;
        if (more) { const bf16_t* k2 = gk + (size_t)(it + 1) * 64 * QLD; const bf16_t* v2 = gv + (it + 1) * 64; r0 = *(const u32x4*)k2; r1 = *(const u32x4*)(k2 + 64); r2 = *(const u32x4*)v2; r3 = *(const u32x4*)(v2 + (size_t)64 * SEQ); }
        const char* buf = lds + (it & 1) * STG;
        attn_tile<4, false>(buf + j * KT_BYTES, buf + 2 * KT_BYTES, qf, o, m, l, r, h, nullptr, 0, sinit, it == 0);
        if (more) { char* d = lds + ((it + 1) & 1) * STG + lw; *(u32x4*)d = r0; *(u32x4*)(d + KT_BYTES) = r1; *(u32x4*)(d + 2 * KT_BYTES) = r2; *(u32x4*)(d + 3 * KT_BYTES) = r3; }
        __syncthreads();
    }
    l += __shfl_xor(l, 32);
    const float inv = 1.0f / l;
    float* xch = (float*)lds;
    if (j == 1) {
#pragma unroll
        for (int db = 0; db < 4; ++db)
#pragma unroll
            for (int i = 0; i < 16; ++i) xch[((qs * 4 + db) * 16 + i) * 64 + lane] = o[db][i] * inv;
    }
    __syncthreads();
    if (j == 0) {
        float ss = 0.f;
#pragma unroll
        for (int db = 0; db < 4; ++db)
#pragma unroll
            for (int i = 0; i < 16; ++i) { const float v = o[db][i] * inv - lam * xch[((qs * 4 + db) * 16 + i) * 64 + lane]; o[db][i] = v; ss += v * v; }
        ss += __shfl_xor(ss, 32);
        const float rs = __builtin_amdgcn_rsqf(ss * (1.0f / 128.0f) + EPS) * (1.0f - lam_init);
#pragma unroll
        for (int db = 0; db < 4; ++db)
#pragma unroll
            for (int g4 = 0; g4 < 4; ++g4) {
                const int d = 32 * db + 8 * g4 + 4 * h; const f32x4 gv4 = *(const f32x4*)(subln + d);
                st_bf4(mix + (size_t)tq * DM + hd * 128 + d, o[db][4 * g4] * rs * gv4[0], o[db][4 * g4 + 1] * rs * gv4[1], o[db][4 * g4 + 2] * rs * gv4[2], o[db][4 * g4 + 3] * rs * gv4[3]);
            }
    }
    __syncthreads();
}

DI void attn_na_unit(char* lds, const bf16_t* __restrict__ qkb, const bf16_t* __restrict__ cvt, bf16_t* __restrict__ mix, int u, const float* __restrict__ bias) {
    const int tid = tidx(), lane = tid & 63, wid = __builtin_amdgcn_readfirstlane(tid >> 6), r = lane & 31, h = lane >> 5;
    const int hg = u & 3, R = (u >> 2) & 127, b = u >> 9;
    const int hw = wid & 3, head = 4 * hg + hw, qc = (wid >> 2) * 32 + r;
    const int tq = b * SEQ + R * 64 + qc;
    int rs = R - 4; rs = rs < 0 ? 0 : (rs > 120 ? 120 : rs);
    constexpr int STG = 8 * KT_BYTES;
    bf16x8 qf[4];
#pragma unroll
    for (int t = 0; t < 4; ++t) qf[t] = *(const bf16x8*)(qkb + (size_t)tq * QLD + head * 64 + 16 * t + 8 * h);
    f32x16 o[2];
#pragma unroll
    for (int db = 0; db < 2; ++db)
#pragma unroll
        for (int i = 0; i < 16; ++i) o[db][i] = 0.f;
    float m = 0.f, l = 0.f;
    f32x16 sinit;
#pragma unroll
    for (int i = 0; i < 16; ++i) sinit[i] = 0.f;
    const int lrow = tid >> 3, lkc = tid & 7, lw = lrow * LROW + lkc * 16;
    const bf16_t* gk = qkb + (size_t)(b * SEQ + rs * 64 + lrow) * QLD + 1024 + (4 * hg) * 64 + lkc * 8;
    const bf16_t* gv = cvt + (size_t)((b * 16 + 4 * hg) * 64 + lrow) * SEQ + rs * 64 + lkc * 8;
    float* lb = (float*)(lds + 4 * GT_BYTES);
    for (int i = tid; i < 4 * 465; i += NTHREADS) lb[i] = bias[(size_t)hg * 4 * 465 + i] * LOG2E;
    u32x4 rk[4], rv[4];
#pragma unroll
    for (int hd = 0; hd < 4; ++hd) { rk[hd] = *(const u32x4*)(gk + 64 * hd); rv[hd] = *(const u32x4*)(gv + (size_t)hd * 64 * SEQ); }
#pragma unroll
    for (int hd = 0; hd < 4; ++hd) { *(u32x4*)(lds + (2 * hd) * KT_BYTES + lw) = rk[hd]; *(u32x4*)(lds + (2 * hd + 1) * KT_BYTES + lw) = rv[hd]; }
#pragma unroll
    for (int t = 0; t < 4; ++t) asm volatile("" : "+v"(qf[t]));
    __syncthreads();
#pragma unroll 1
    for (int it = 0; it < 8; ++it) {
        const bool more = it + 1 < 8;
        if (more) {
#pragma unroll
            for (int hd = 0; hd < 4; ++hd) { rk[hd] = *(const u32x4*)(gk + (size_t)(it + 1) * 64 * QLD + 64 * hd); rv[hd] = *(const u32x4*)(gv + (size_t)hd * 64 * SEQ + (it + 1) * 64); }
        }
        const char* buf = lds + (it & 1) * STG + (2 * hw) * KT_BYTES;
        const float* brow = lb + (hw * 15 + (rs + it - R + 7)) * 31;
        attn_tile<2, true>(buf, buf + KT_BYTES, qf, o, m, l, r, h, brow, qc, sinit, it == 0);
        if (more) {
            char* d = lds + ((it + 1) & 1) * STG + lw;
#pragma unroll
            for (int hd = 0; hd < 4; ++hd) { *(u32x4*)(d + (2 * hd) * KT_BYTES) = rk[hd]; *(u32x4*)(d + (2 * hd + 1) * KT_BYTES) = rv[hd]; }
        }
        __syncthreads();
    }
    l += __shfl_xor(l, 32);
    const float inv = 1.0f / l;
#pragma unroll
    for (int db = 0; db < 2; ++db)
#pragma unroll
        for (int g4 = 0; g4 < 4; ++g4)
            st_bf4(mix + (size_t)tq * DM + head * 64 + 32 * db + 8 * g4 + 4 * h, o[db][4 * g4] * inv, o[db][4 * g4 + 1] * inv, o[db][4 * g4 + 2] * inv, o[db][4 * g4 + 3] * inv);
}


#define XB_TMO      128
#define XB_XCNT(j)  (256  + 64 * (j))
#define XB_XSUB(j)  (1280 + 64 * (j))
#define XB_XGEN(j)  (2304 + 64 * (j))
#define XB_TOP      3328
#define XB_TOPGEN   3392
#define XCD_BAR_WORDS 3456
#define XB_SPIN_CAP (1u << 23)
#define LAS __attribute__((address_space(3)))
DI unsigned xb_ld(unsigned* p)              { return __hip_atomic_load(p, __ATOMIC_RELAXED, __HIP_MEMORY_SCOPE_AGENT); }
DI unsigned xb_add(unsigned* p, unsigned v) { return __hip_atomic_fetch_add(p, v, __ATOMIC_RELAXED, __HIP_MEMORY_SCOPE_AGENT); }
DI unsigned xb_xcc_id() { return (unsigned)__builtin_amdgcn_s_getreg((3 << 11) | 20) & 0xFu; }
#define XB_SPIN(cond, bar) do { unsigned _sp = 0; while (cond) { __builtin_amdgcn_s_sleep(1); \
    if ((++_sp & 255u) == 0u) { if (xb_ld(&(bar)[XB_TMO])) break; if (_sp > XB_SPIN_CAP) { atomicAdd(&(bar)[XB_TMO], 1u); break; } } } } while (0)
struct XcdBarrier { unsigned* bar; unsigned x; volatile LAS unsigned* st; unsigned slot; };
DI XcdBarrier xcd_barrier_post(unsigned* bar, volatile LAS unsigned* st) {
    XcdBarrier b; b.bar = bar; b.x = xb_xcc_id(); b.st = st; b.slot = 0u;
    if (threadIdx.x == 0) b.slot = xb_add(&bar[XB_XCNT(b.x)], 1u);
    return b;
}
DI void xcd_barrier_complete(unsigned* bar, unsigned x, unsigned& nloc, unsigned& nx) {
    const unsigned G = gridDim.x * gridDim.y * gridDim.z;
    unsigned sum, cnt, mine, sp = 0u;
    for (;;) {
        sum = 0u; cnt = 0u; mine = 0u;
#pragma unroll
        for (unsigned j = 0; j < 16; ++j) { const unsigned c = xb_ld(&bar[XB_XCNT(j)]); sum += c; cnt += (c > 0u) ? 1u : 0u; mine = (j == x) ? c : mine; }
        if (sum == G) break;
        __builtin_amdgcn_s_sleep(1);
        if ((++sp & 255u) == 0u) { if (xb_ld(&bar[XB_TMO])) break; if (sp > XB_SPIN_CAP) { atomicAdd(&bar[XB_TMO], 1u); break; } }
    }
    nloc = mine > 0u ? mine : 1u; nx = cnt > 0u ? cnt : 1u;
}
DI void xcd_barrier(const XcdBarrier& b) {
    asm volatile("s_waitcnt vmcnt(0)" ::: "memory");
    __syncthreads();
    if (threadIdx.x == 0) {
        unsigned* bar = b.bar;
        __builtin_amdgcn_s_waitcnt(0);
        unsigned nloc = b.st[0], nx = b.st[1];
        if (nloc == 0u) { xcd_barrier_complete(bar, b.x, nloc, nx); b.st[0] = nloc; b.st[1] = nx; }
        const unsigned old = xb_add(&bar[XB_XSUB(b.x)], 1u);
        const unsigned gen = old / nloc;
        if (old + 1u == (gen + 1u) * nloc) {
            __builtin_amdgcn_fence(__ATOMIC_RELEASE, "agent");
            asm volatile("s_waitcnt vmcnt(0)" ::: "memory");
            const unsigned og = xb_add(&bar[XB_TOP], 1u);
            const unsigned tg = og / nx;
            if (og + 1u == (tg + 1u) * nx) xb_add(&bar[XB_TOPGEN], 1u);
            else XB_SPIN(xb_ld(&bar[XB_TOPGEN]) == tg, bar);
            __builtin_amdgcn_fence(__ATOMIC_ACQUIRE, "agent");
            xb_add(&bar[XB_XGEN(b.x)], 1u);
            asm volatile("s_waitcnt vmcnt(0)" ::: "memory");
        } else {
            XB_SPIN(xb_ld(&bar[XB_XGEN(b.x)]) == gen, bar);
            __builtin_amdgcn_fence(__ATOMIC_ACQUIRE, "agent");
            asm volatile("s_waitcnt vmcnt(0)" ::: "memory");
        }
    }
    __syncthreads();
}

__global__ void __launch_bounds__(NTHREADS) fwd_megakernel(Params P) {
    extern __shared__ __attribute__((aligned(16))) char lds[];
    cg::grid_group grid = cg::this_grid();
    volatile LAS unsigned* xst = (volatile LAS unsigned*)(lds + LDS_BYTES - 16);
    if (threadIdx.x == 0) { xst[0] = 0u; xst[1] = 0u; }
    __syncthreads();
    const XcdBarrier xb = xcd_barrier_post((unsigned*)(P.ws + OFF_BAR), xst);
    char* ws = P.ws;
    bf16_t* H = (bf16_t*)(ws + OFF_H); bf16_t* QKB = (bf16_t*)(ws + OFF_QKB); bf16_t* VT = (bf16_t*)(ws + OFF_VT);
    bf16_t* ACT = (bf16_t*)(ws + OFF_ACT); bf16_t* MIX = (bf16_t*)(ws + OFF_MIX); float* HALO = (float*)(ws + OFF_HALO); bf16_t* PB = (bf16_t*)(ws + OFF_PB);
    const f32x2* ROPEA = (const f32x2*)(ws + OFF_ROPEA); const f32x2* ROPEB = (const f32x2*)(ws + OFF_ROPEB);
    float* X = P.out;
    bf16_t* AVT = VT; bf16_t* BVT = VT + (size_t)4 * 4 * 128 * SEQ;

    float* SSQ = (float*)(ws + OFF_SSQ);
    phase_prep(P, lds);
    phase_x0(P.x, MIX, SSQ);
    phase_cvt_p(P.p, PB);
    grid.sync();
    int vbid = blockIdx.x;
    {
        volatile LAS unsigned* vst = (volatile LAS unsigned*)(lds + LDS_BYTES - 32);
        if (threadIdx.x == 0) {
            unsigned* bar = (unsigned*)(P.ws + OFF_BAR); bool ok = (gridDim.x & 7) == 0;
            for (unsigned jx = 0; jx < 16; ++jx) { const unsigned c = xb_ld(&bar[XB_XCNT(jx)]); ok = ok && (c == (jx < 8 ? gridDim.x / 8 : 0u)); }
            vst[0] = ok ? xb.slot * 8u + xb.x : blockIdx.x;
        }
        __syncthreads();
        vbid = (int)vst[0];
        __syncthreads();
    }

#pragma unroll 1
    for (int l = 0; l < 4; ++l) {
        const bf16_t* wl = (const bf16_t*)(ws + OFF_WB) + (size_t)l * WL_ELEMS; const int j = l >> 1;
        const float* xres = l == 0 ? P.x : X;
        float* ssq_a = SSQ + (size_t)(3 * l) * T_TOK * 16; float* ssq_f = ssq_a + (size_t)T_TOK * 16; float* ssq_p = ssq_f + (size_t)T_TOK * 16; float* ssq_n = ssq_p + (size_t)T_TOK * 16;
        if ((l & 1) == 0) {
            EpiInEven e{QKB, AVT, BVT, ROPEA, ROPEB, P.bq_norm + j * 64, P.bk_norm + j * 64, ssq_a};
            gemm_phase(lds, MIX, DM, wl + WL_WIN, 1024, 2304, e, vbid);
            xcd_barrier(xb);
            const float lam_init = j == 0 ? P.lam_init[0] : P.lam_init[1];
            float lam;
            { const int lane = threadIdx.x & 63; float a = P.lq1[j * 64 + lane] * P.lk1[j * 64 + lane], c = P.lq2[j * 64 + lane] * P.lk2[j * 64 + lane];
#pragma unroll
              for (int o = 32; o >= 1; o >>= 1) { a += __shfl_xor(a, o); c += __shfl_xor(c, o); }
              lam = __expf(a) - __expf(c) + lam_init; }
            for (int u = vbid; u < 1536; u += gridDim.x) {
                if (u < 1024) attn_diff_unit(lds, QKB, AVT, MIX, u, lam, lam_init, P.a_subln + j * 128);
                else attn_gqa2_unit(lds, QKB, BVT, MIX, u - 1024);
            }
            xcd_barrier(xb);
        } else {
            EpiInOdd e{QKB, VT, ssq_a};
            gemm_phase(lds, MIX, DM, wl + WL_WIN, 1024, 3072, e, vbid);
            xcd_barrier(xb);
            for (int u = vbid; u < 2048; u += gridDim.x) attn_na_unit(lds, QKB, VT, MIX, u, P.c_rel_bias + (size_t)j * 16 * 15 * 31);
            xcd_barrier(xb);
        }
        { EpiResid e{xres, X, H, ssq_f}; gemm_phase(lds, MIX, DM, wl + WL_WOUT, 1024, 1024, e, vbid); }
        xcd_barrier(xb);
        { EpiUp e{ACT, HALO, P.conv_w + (size_t)l * 3 * 5632, P.conv_b + (size_t)l * 5632, ssq_f}; gemm_phase(lds, H, DM, wl + WL_WUP, 1024, 5632, e, vbid); }
        { EpiBf16 e{MIX}; gemm_phase(lds, PB, PLE, wl + WL_WPROJ, 256, 1024, e, vbid); }
        xcd_barrier(xb);
        phase_fix(HALO, ACT, P.conv_w + (size_t)l * 3 * 5632, P.conv_b + (size_t)l * 5632);
        if (l < 3) phase_cvt_p(P.p + (size_t)(l + 1) * T_TOK * PLE, PB);
        xcd_barrier(xb);
        { EpiResid e{X, X, H, ssq_p}; gemm_phase(lds, ACT, DFF, wl + WL_WDOWN, 2816, 1024, e, vbid); }
        xcd_barrier(xb);
        { EpiPle e{X, MIX, ssq_p, ssq_n}; gemm_phase(lds, H, DM, wl + WL_WGATE, 1024, 1024, e, vbid); }
        xcd_barrier(xb);
    }
    phase_final_norm(X, P.final_norm);
}

extern "C" void kernel_launch(void* const* d_in, const int* in_sizes, int n_in, void* d_out, int out_size, void* d_ws, size_t ws_size, hipStream_t stream) {
    static int grid_blocks = 0;
    if (!grid_blocks) {
        int dev = 0, cus = 0, per_cu = 0;
        hipGetDevice(&dev);
        hipDeviceGetAttribute(&cus, hipDeviceAttributeMultiprocessorCount, dev);
        if (hipFuncSetAttribute((const void*)fwd_megakernel, hipFuncAttributeMaxDynamicSharedMemorySize, LDS_BYTES) != hipSuccess) fprintf(stderr, "hipFuncSetAttribute failed\n");
        hipOccupancyMaxActiveBlocksPerMultiprocessor(&per_cu, (const void*)fwd_megakernel, NTHREADS, LDS_BYTES);
        if (per_cu < 1) { fprintf(stderr, "occupancy query returned %d\n", per_cu); per_cu = 1; }
        grid_blocks = cus * 1;
    }
    if (ws_size < WS_NEEDED) { fprintf(stderr, "workspace too small: %zu < %zu\n", ws_size, (size_t)WS_NEEDED); return; }
    Params P{};
    const float* const* in = (const float* const*)d_in;
    P.x = in[0]; P.p = in[1]; P.attn_norm = in[2]; P.w_in_ab = in[3]; P.lq1 = in[4]; P.lk1 = in[5]; P.lq2 = in[6]; P.lk2 = in[7];
    P.a_subln = in[8]; P.bq_norm = in[9]; P.bk_norm = in[10]; P.w_out_ab = in[11]; P.w_in_c = in[12]; P.c_rel_bias = in[13]; P.w_out_c = in[14];
    P.ffn_norm = in[15]; P.w_ffn_up = in[16]; P.conv_w = in[17]; P.conv_b = in[18]; P.w_ffn_down = in[19]; P.ple_norm = in[20];
    P.w_ple_gate = in[21]; P.w_ple_proj = in[22]; P.final_norm = in[23];
    P.out = (float*)d_out; P.ws = (char*)d_ws;
    for (int i = 0; i < 8; ++i) P.inv_a[i] = powf(500000.0f, -(float)i / 8.0f);
    for (int i = 0; i < 16; ++i) P.inv_b[i] = powf(10000.0f, -(float)i / 16.0f);
    P.lam_init[0] = (float)(0.8 - 0.6 * exp(-0.3 * 0.0)); P.lam_init[1] = (float)(0.8 - 0.6 * exp(-0.3 * 2.0)); P.lam_init[2] = 0.f; P.lam_init[3] = 0.f;
    hipMemsetAsync((char*)d_ws + OFF_BAR, 0, 16384, stream);
    void* args[] = {&P};
    hipError_t e = hipLaunchCooperativeKernel((const void*)fwd_megakernel, dim3(grid_blocks), dim3(NTHREADS), args, LDS_BYTES, stream);
    if (e != hipSuccess) fprintf(stderr, "cooperative launch failed: %s (grid %d)\n", hipGetErrorString(e), grid_blocks);
}
```

```cpp
#include <hip/hip_runtime.h>
#include <hip/hip_cooperative_groups.h>
#include <cstdio>
#include <cmath>
#include <cstdint>
namespace cg = cooperative_groups;

typedef unsigned short bf16_t;
typedef short bf16x8 __attribute__((ext_vector_type(8)));
typedef float f32x16 __attribute__((ext_vector_type(16)));
typedef float f32x4 __attribute__((ext_vector_type(4)));
typedef float f32x2 __attribute__((ext_vector_type(2)));
typedef unsigned u32x4 __attribute__((ext_vector_type(4)));
typedef unsigned u32x2 __attribute__((ext_vector_type(2)));
typedef __bf16 bf16v2 __attribute__((ext_vector_type(2)));

#define DI __device__ __forceinline__

constexpr int T_TOK = 32768, SEQ = 8192, DM = 1024, DFF = 2816, PLE = 256;
constexpr float EPS = 1e-6f;
constexpr float QSCALE = 0.125f * 1.4426950408889634f;
constexpr float LOG2E = 1.4426950408889634f;
constexpr int NTHREADS = 512;
constexpr int LROW = 144;
constexpr int GT_BYTES = 256 * LROW;
constexpr int LDS_BYTES = 4 * GT_BYTES + 8192 + 512;

constexpr size_t MiB = 1024 * 1024;
constexpr size_t OFF_ROPEA = 0;
constexpr size_t OFF_ROPEB = 524288;
constexpr size_t OFF_BAR = 640 * 1024;
constexpr size_t OFF_WB = 1 * MiB;
constexpr size_t WL_WIN = 0, WL_WOUT = 3145728, WL_WUP = WL_WOUT + 1048576, WL_WDOWN = WL_WUP + 5767168,
                 WL_WGATE = WL_WDOWN + 2883584, WL_WPROJ = WL_WGATE + 1048576, WL_ELEMS = WL_WPROJ + 262144;
constexpr size_t OFF_H = OFF_WB + 108 * MiB;
constexpr size_t OFF_QKB = OFF_H + 64 * MiB;
constexpr size_t OFF_VT = OFF_QKB + 128 * MiB;
constexpr size_t OFF_ACT = OFF_QKB;
constexpr size_t OFF_MIX = OFF_VT + 64 * MiB;
constexpr size_t OFF_HALO = OFF_MIX + 64 * MiB;
constexpr size_t OFF_PB = OFF_HALO + 22 * MiB;
constexpr size_t OFF_SSQ = OFF_PB + 16 * MiB;
constexpr size_t WS_NEEDED = OFF_SSQ + 26 * MiB;
static_assert(WL_ELEMS * 2 * 4 <= 108 * MiB, "weights");
constexpr int QLD = 2048;
constexpr int SREG_BYTES = 18432;

struct Params {
    const float* x; const float* p; const float* attn_norm; const float* w_in_ab;
    const float* lq1; const float* lk1; const float* lq2; const float* lk2;
    const float* a_subln; const float* bq_norm; const float* bk_norm; const float* w_out_ab;
    const float* w_in_c; const float* c_rel_bias; const float* w_out_c; const float* ffn_norm;
    const float* w_ffn_up; const float* conv_w; const float* conv_b; const float* w_ffn_down;
    const float* ple_norm; const float* w_ple_gate; const float* w_ple_proj; const float* final_norm;
    float* out; char* ws;
    float inv_a[8]; float inv_b[16]; float lam_init[4];
};

DI unsigned pk2(float lo, float hi) { f32x2 v = {lo, hi}; return __builtin_bit_cast(unsigned, __builtin_convertvector(v, bf16v2)); }
DI float bf2f(bf16_t b) { return __uint_as_float(((unsigned)b) << 16); }
DI f32x16 mfma32(bf16x8 a, bf16x8 b, f32x16 c) { return __builtin_amdgcn_mfma_f32_32x32x16_bf16(a, b, c, 0, 0, 0); }
DI float fexp2(float x) { return __builtin_amdgcn_exp2f(x); }
DI float frcp(float x) { return __builtin_amdgcn_rcpf(x); }
DI float xhalf_max(float x) { return fmaxf(x, __shfl_xor(x, 32)); }
DI float xhalf_sum(float x) { return x + __shfl_xor(x, 32); }
DI float sigmoidf_(float x) { return frcp(1.0f + fexp2(-x * LOG2E)); }

DI int tidx() { int t = threadIdx.x; asm volatile("" : "+v"(t)); return t; }

template <bool PERM_UP>
DI void convert_weight(char* lds, const float* __restrict__ src, bf16_t* __restrict__ dst, int K, int N, const float* __restrict__ gain = nullptr) {
    float* tile = (float*)lds;
    const int tid = tidx();
    const int ntk = K / 64, ntn = N / 64, nt = ntk * ntn;
    for (int t = blockIdx.x; t < nt; t += gridDim.x) {
        const int k0 = (t / ntn) * 64, n0 = (t % ntn) * 64;
#pragma unroll
        for (int i = 0; i < 8; ++i) { const int idx = tid + NTHREADS * i, k = idx >> 6, n = idx & 63; tile[k * 65 + n] = src[(size_t)(k0 + k) * N + n0 + n] * (gain ? gain[k0 + k] : 1.0f); }
        __syncthreads();
#pragma unroll
        for (int i = 0; i < 4; ++i) {
            const int idx = tid + NTHREADS * i, n = idx >> 5, k2 = idx & 31;
            int nn = n0 + n;
            if (PERM_UP) { const int c = nn < DFF ? nn : nn - DFF; nn = (c >> 5) * 64 + (nn < DFF ? 0 : 32) + (c & 31); }
            *(unsigned*)(dst + (size_t)nn * K + k0 + 2 * k2) = pk2(tile[(2 * k2) * 65 + n], tile[(2 * k2 + 1) * 65 + n]);
        }
        __syncthreads();
    }
}

DI void sincos_acc(float angf, float& sn, float& cs) {
    const double x = (double)angf;
    const double k = __builtin_rint(x * 0.15915494309189535);
    double y = __builtin_fma(-k, 6.283185307179586, x); y = __builtin_fma(-k, 2.4492935982947064e-16, y);
    const double y2 = y * y;
    double ts = y, s = y, tc = 1.0, c = 1.0;
#pragma unroll 1
    for (int n = 1; n <= 14; ++n) {
        tc *= -y2 / (double)((2 * n - 1) * (2 * n)); c += tc;
        ts *= -y2 / (double)((2 * n) * (2 * n + 1)); s += ts;
    }
    sn = (float)s; cs = (float)c;
}

DI void phase_prep(const Params& P, char* lds) {
    bf16_t* wb = (bf16_t*)(P.ws + OFF_WB);
    for (int l = 0; l < 4; ++l) {
        bf16_t* wl = wb + (size_t)l * WL_ELEMS; const int j = l >> 1;
        if ((l & 1) == 0) { convert_weight<false>(lds, P.w_in_ab + (size_t)j * 1024 * 2304, wl + WL_WIN, 1024, 2304, P.attn_norm + l * DM); convert_weight<false>(lds, P.w_out_ab + (size_t)j * 1024 * 1024, wl + WL_WOUT, 1024, 1024); }
        else { convert_weight<false>(lds, P.w_in_c + (size_t)j * 1024 * 3072, wl + WL_WIN, 1024, 3072, P.attn_norm + l * DM); convert_weight<false>(lds, P.w_out_c + (size_t)j * 1024 * 1024, wl + WL_WOUT, 1024, 1024); }
        convert_weight<true>(lds, P.w_ffn_up + (size_t)l * 1024 * 5632, wl + WL_WUP, 1024, 5632, P.ffn_norm + l * DM);
        convert_weight<false>(lds, P.w_ffn_down + (size_t)l * 2816 * 1024, wl + WL_WDOWN, 2816, 1024);
        convert_weight<false>(lds, P.w_ple_gate + (size_t)l * 1024 * 1024, wl + WL_WGATE, 1024, 1024, P.ple_norm + l * DM);
        convert_weight<false>(lds, P.w_ple_proj + (size_t)l * 256 * 1024, wl + WL_WPROJ, 256, 1024);
    }
    f32x2* ra = (f32x2*)(P.ws + OFF_ROPEA); f32x2* rb = (f32x2*)(P.ws + OFF_ROPEB);
    for (int i = blockIdx.x * NTHREADS + tidx(); i < 8192 + 128; i += gridDim.x * NTHREADS) {
        float sn, cs;
        if (i < 8192) {
#pragma unroll
            for (int k = 0; k < 8; ++k) { const float ang = (float)i * P.inv_a[k]; sincos_acc(ang, sn, cs); ra[i * 8 + k] = (f32x2){cs, sn}; }
        } else {
            const int q = i - 8192;
#pragma unroll
            for (int k = 0; k < 16; ++k) { const float ang = (float)q * P.inv_b[k]; sincos_acc(ang, sn, cs); rb[q * 16 + k] = (f32x2){cs, sn}; }
        }
    }
}

DI void phase_x0(const float* __restrict__ src, bf16_t* __restrict__ dst, float* __restrict__ ssq) {
    const int lane = tidx() & 63, wv = blockIdx.x * 8 + (tidx() >> 6), nw = gridDim.x * 8;
    for (int row = wv; row < T_TOK; row += nw) {
        const float* sp = src + (size_t)row * DM; f32x4 v[4]; float ss = 0.f;
#pragma unroll
        for (int i = 0; i < 4; ++i) { v[i] = *(const f32x4*)(sp + (i * 64 + lane) * 4); ss += v[i][0] * v[i][0] + v[i][1] * v[i][1] + v[i][2] * v[i][2] + v[i][3] * v[i][3]; }
#pragma unroll
        for (int o = 32; o >= 1; o >>= 1) ss += __shfl_xor(ss, o);
#pragma unroll
        for (int i = 0; i < 4; ++i) { u32x2 w; w.x = pk2(v[i][0], v[i][1]); w.y = pk2(v[i][2], v[i][3]); *(u32x2*)(dst + (size_t)row * DM + (i * 64 + lane) * 4) = w; }
        if (lane < 16) ssq[(size_t)lane * T_TOK + row] = lane == 0 ? ss : 0.f;
    }
}
DI float rstd_of(float ssq) { return __builtin_amdgcn_rsqf(ssq * (1.0f / DM) + EPS); }
DI float* wave_rstd_table(const float* __restrict__ ssqp, int tok0w, const char* xtra, int lane) {
    float* tbl = (float*)(xtra + 4096) + (tidx() >> 6) * 128;
    {
        const float* p = ssqp + tok0w + 2 * lane;
        f32x2 a[16];
#pragma unroll
        for (int i = 0; i < 16; ++i) a[i] = *(const f32x2*)(p + (size_t)i * T_TOK);
        const f32x2 t = (((a[0] + a[1]) + (a[2] + a[3])) + ((a[4] + a[5]) + (a[6] + a[7]))) + (((a[8] + a[9]) + (a[10] + a[11])) + ((a[12] + a[13]) + (a[14] + a[15])));
        *(f32x2*)(tbl + 2 * lane) = (f32x2){rstd_of(t.x), rstd_of(t.y)};
    }
    return tbl;
}

DI void phase_norm(const float* __restrict__ src, const float* __restrict__ g, bf16_t* __restrict__ dst) {
    const int lane = tidx() & 63, wv = blockIdx.x * 8 + (tidx() >> 6), nw = gridDim.x * 8;
    f32x4 gv[4];
#pragma unroll
    for (int i = 0; i < 4; ++i) gv[i] = *(const f32x4*)(g + (i * 64 + lane) * 4);
    for (int row = wv; row < T_TOK; row += nw) {
        const float* s = src + (size_t)row * DM; f32x4 v[4]; float ss = 0.f;
#pragma unroll
        for (int i = 0; i < 4; ++i) { v[i] = *(const f32x4*)(s + (i * 64 + lane) * 4); ss += v[i][0] * v[i][0] + v[i][1] * v[i][1] + v[i][2] * v[i][2] + v[i][3] * v[i][3]; }
#pragma unroll
        for (int o = 32; o >= 1; o >>= 1) ss += __shfl_xor(ss, o);
        const float rs = __builtin_amdgcn_rsqf(ss * (1.0f / DM) + EPS);
#pragma unroll
        for (int i = 0; i < 4; ++i) { u32x2 w; w.x = pk2(v[i][0] * rs * gv[i][0], v[i][1] * rs * gv[i][1]); w.y = pk2(v[i][2] * rs * gv[i][2], v[i][3] * rs * gv[i][3]); *(u32x2*)(dst + (size_t)row * DM + (i * 64 + lane) * 4) = w; }
    }
}
DI void phase_final_norm(float* __restrict__ x, const float* __restrict__ g) {
    const int lane = tidx() & 63, wv = blockIdx.x * 8 + (tidx() >> 6), nw = gridDim.x * 8;
    f32x4 gv[4];
#pragma unroll
    for (int i = 0; i < 4; ++i) gv[i] = *(const f32x4*)(g + (i * 64 + lane) * 4);
    for (int row = wv; row < T_TOK; row += nw) {
        float* s = x + (size_t)row * DM; f32x4 v[4]; float ss = 0.f;
#pragma unroll
        for (int i = 0; i < 4; ++i) { v[i] = *(const f32x4*)(s + (i * 64 + lane) * 4); ss += v[i][0] * v[i][0] + v[i][1] * v[i][1] + v[i][2] * v[i][2] + v[i][3] * v[i][3]; }
#pragma unroll
        for (int o = 32; o >= 1; o >>= 1) ss += __shfl_xor(ss, o);
        const float rs = __builtin_amdgcn_rsqf(ss * (1.0f / DM) + EPS);
#pragma unroll
        for (int i = 0; i < 4; ++i) *(f32x4*)(s + (i * 64 + lane) * 4) = v[i] * rs * gv[i];
    }
}
DI void phase_cvt_p(const float* __restrict__ src, bf16_t* __restrict__ dst) {
    const size_t n4 = (size_t)T_TOK * PLE / 4;
    for (size_t i = (size_t)blockIdx.x * NTHREADS + tidx(); i < n4; i += (size_t)gridDim.x * NTHREADS) {
        const f32x4 v = *(const f32x4*)(src + i * 4); u32x2 w; w.x = pk2(v[0], v[1]); w.y = pk2(v[2], v[3]); *(u32x2*)(dst + i * 4) = w;
    }
}

template <class Epi, bool SWP>
DI void gemm_tile(char* lds, const bf16_t* __restrict__ A, int lda, const bf16_t* __restrict__ Bt, int K, int tok0, int col0, const Epi& epi) {
    const int tid = tidx(), lane = tid & 63, wid = __builtin_amdgcn_readfirstlane(tid >> 6), wm = wid & 1, wn = wid >> 1, r = lane & 31, h = lane >> 5;
    const int lrow = tid >> 3, lkc = tid & 7;
    const bf16_t* ga = A + (size_t)(tok0 + lrow) * lda + lkc * 8;
    const bf16_t* gb = Bt + (size_t)(col0 + lrow) * K + lkc * 8;
    const int lw = lrow * LROW + lkc * 16;
    int lwa[4];
#pragma unroll
    for (int i = 0; i < 4; ++i) {
        if (Epi::PERM_TOK) { const int gr = lrow + 64 * i, tau = gr & 127; lwa[i] = ((gr & 128) + (tau & 3) * 32 + (tau >> 2)) * LROW + lkc * 16; }
        else lwa[i] = lw + 64 * i * LROW;
    }
    u32x4 ra[4], rb[4];
#pragma unroll
    for (int i = 0; i < 4; ++i) { ra[i] = *(const u32x4*)(ga + (size_t)(64 * i) * lda); rb[i] = *(const u32x4*)(gb + (size_t)(64 * i) * K); }
    epi.tile_prologue(lds, col0, tid);
    f32x16 acc[2][4];
#pragma unroll
    for (int a = 0; a < 2; ++a)
#pragma unroll
        for (int b = 0; b < 4; ++b)
#pragma unroll
            for (int i = 0; i < 16; ++i) acc[a][b][i] = 0.f;
#pragma unroll
    for (int i = 0; i < 4; ++i) { *(u32x4*)(lds + lwa[i]) = ra[i]; *(u32x4*)(lds + GT_BYTES + lw + 64 * i * LROW) = rb[i]; }
    __syncthreads();
    const int nk = K / 64;
    if (nk > 1) {
#pragma unroll
        for (int i = 0; i < 4; ++i) { ra[i] = *(const u32x4*)(ga + (size_t)(64 * i) * lda + 64); rb[i] = *(const u32x4*)(gb + (size_t)(64 * i) * K + 64); }
    }
#pragma unroll 1
    for (int kt = 0; kt < nk; ++kt) {
        const bool more = kt + 1 < nk, more2 = kt + 2 < nk;
        const char* sa = lds + (kt & 1) * 2 * GT_BYTES + (wm * 128 + r) * LROW + h * 16;
        const char* sb = lds + (kt & 1) * 2 * GT_BYTES + GT_BYTES + (wn * 64 + r) * LROW + h * 16;
        bf16x8 wf[2][2], xf[2][4];
#pragma unroll
        for (int fb = 0; fb < 2; ++fb) wf[0][fb] = *(const bf16x8*)(sb + fb * 32 * LROW);
#pragma unroll
        for (int tb = 0; tb < 4; ++tb) xf[0][tb] = *(const bf16x8*)(sa + tb * 32 * LROW);
#pragma unroll
        for (int t = 0; t < 4; ++t) {
            if (t < 3) {
#pragma unroll
                for (int fb = 0; fb < 2; ++fb) wf[(t + 1) & 1][fb] = *(const bf16x8*)(sb + fb * 32 * LROW + (t + 1) * 32);
#pragma unroll
                for (int tb = 0; tb < 4; ++tb) xf[(t + 1) & 1][tb] = *(const bf16x8*)(sa + tb * 32 * LROW + (t + 1) * 32);
            }
            if (t == 3 && more) {
                char* d = lds + ((kt + 1) & 1) * 2 * GT_BYTES;
#pragma unroll
                for (int i = 0; i < 4; ++i) { *(u32x4*)(d + lwa[i]) = ra[i]; *(u32x4*)(d + GT_BYTES + lw + 64 * i * LROW) = rb[i]; }
                if (more2) {
#pragma unroll
                    for (int i = 0; i < 4; ++i) { ra[i] = *(const u32x4*)(ga + (size_t)(64 * i) * lda + (kt + 2) * 64); rb[i] = *(const u32x4*)(gb + (size_t)(64 * i) * K + (kt + 2) * 64); }
                }
                __builtin_amdgcn_sched_barrier(0);
            }
#pragma unroll
            for (int fb = 0; fb < 2; ++fb)
#pragma unroll
                for (int tb = 0; tb < 4; ++tb) acc[fb][tb] = SWP ? mfma32(wf[t & 1][fb], xf[t & 1][tb], acc[fb][tb]) : mfma32(xf[t & 1][tb], wf[t & 1][fb], acc[fb][tb]);
            __builtin_amdgcn_sched_barrier(0);
        }
        __syncthreads();
    }
    char* sreg = lds + wid * SREG_BYTES;
    if (SWP) epi.swp(acc, tok0 + wm * 128, col0 + wn * 64, r, h, sreg, lds + 4 * GT_BYTES); else epi.nsw(acc, tok0 + wm * 128, col0 + wn * 64, r, h, sreg, lds + 4 * GT_BYTES);
    if (Epi::STAGED) __syncthreads();
}

template <class Epi>
DI void gemm_phase(char* lds, const bf16_t* A, int lda, const bf16_t* Bt, int K, int N, const Epi& epi, int vbid) {
    const int nN = N / 256;
    const int wn = __builtin_amdgcn_readfirstlane(tidx() >> 7);
    const int G = gridDim.x, bid = vbid;
    if ((G & 7) == 0) {
        const int x = bid & 7, per = G >> 3, nq = 16 * nN;
        for (int q = bid >> 3; q < nq; q += per) {
            const int tok0 = (16 * x + (q & 7) + 8 * (q / (8 * nN))) * 256, col0 = ((q >> 3) % nN) * 256;
            if (!Epi::HAS_NSW || epi.swapped(col0 + wn * 64)) gemm_tile<Epi, true>(lds, A, lda, Bt, K, tok0, col0, epi);
            else gemm_tile<Epi, false>(lds, A, lda, Bt, K, tok0, col0, epi);
        }
    } else {
        const int nU = (T_TOK / 256) * nN;
        for (int u = bid; u < nU; u += G) {
            const int tok0 = (u / nN) * 256, col0 = (u % nN) * 256;
            if (!Epi::HAS_NSW || epi.swapped(col0 + wn * 64)) gemm_tile<Epi, true>(lds, A, lda, Bt, K, tok0, col0, epi);
            else gemm_tile<Epi, false>(lds, A, lda, Bt, K, tok0, col0, epi);
        }
    }
}

DI void st_bf4(bf16_t* p, float a, float b, float c, float d) { u32x2 w; w.x = pk2(a, b); w.y = pk2(c, d); *(u32x2*)p = w; }
DI void lds_put4(char* p, float a, float b, float c, float d) { u32x2 w; w.x = pk2(a, b); w.y = pk2(c, d); *(u32x2*)p = w; }
template <int NROWS, int ROWB, bool SKIP_EDGES>
DI void stage_flush(const char* sreg, int lane, bf16_t* gbase, size_t gstride) {
    constexpr int CPR = ROWB / 16, TOTAL = NROWS * CPR;
    static_assert(NROWS * (ROWB + 16) <= SREG_BYTES, "staging region");
#pragma unroll
    for (int i = 0; i < TOTAL / 64; ++i) {
        const int idx = lane + 64 * i, row = idx / CPR, ch = idx % CPR;
        const u32x4 v = *(const u32x4*)(sreg + row * (ROWB + 16) + ch * 16);
        if (!SKIP_EDGES || (row != 0 && row != NROWS - 1)) *(u32x4*)(gbase + (size_t)row * gstride + ch * 8) = v;
    }
}

struct EpiInEven {
    bf16_t* qkb; bf16_t* avt; bf16_t* bvt; const f32x2* ropea; const f32x2* ropeb; const float* qn; const float* kn; const float* ssq;
    static constexpr bool HAS_NSW = true, PERM_TOK = false, STAGED = true;
    DI void tile_prologue(char*, int, int) const {}
    DI bool swapped(int f0) const { return !((f0 >= 1024 && f0 < 1536) || f0 >= 2176); }
    DI void nsw(f32x16 (&acc)[2][4], int tok0w, int f0w, int r, int h, char* sreg, const char* xtra) const {
        {
            const float* tbl = wave_rstd_table(ssq, tok0w, xtra, 32 * h + r);
#pragma unroll
            for (int tb = 0; tb < 4; ++tb)
#pragma unroll
                for (int g = 0; g < 4; ++g) { const f32x4 q = *(const f32x4*)(tbl + 32 * tb + 8 * g + 4 * h);
#pragma unroll
                    for (int e = 0; e < 4; ++e) { acc[0][tb][4 * g + e] *= q[e]; acc[1][tb][4 * g + e] *= q[e]; } }
        }
        {
            bf16_t* base; int drow0;
            if (f0w < 1536) { const int c = f0w - 1024; base = avt; drow0 = ((tok0w >> 13) * 4 + (c >> 7)) * 128 + (c & 127); }
            else { const int c = f0w - 2176; base = bvt; drow0 = ((tok0w >> 13) * 2 + (c >> 6)) * 64; }
            const int s0 = tok0w & (SEQ - 1);
#pragma unroll
            for (int fb = 0; fb < 2; ++fb)
#pragma unroll
                for (int tb = 0; tb < 4; ++tb)
#pragma unroll
                    for (int g = 0; g < 4; ++g)
                        lds_put4(sreg + (32 * fb + r) * 272 + (32 * tb + 8 * g + 4 * h) * 2, acc[fb][tb][4 * g], acc[fb][tb][4 * g + 1], acc[fb][tb][4 * g + 2], acc[fb][tb][4 * g + 3]);
            stage_flush<64, 256, false>(sreg, 32 * h + r, base + (size_t)drow0 * SEQ + s0, SEQ);
        }
    }
    DI void swp(f32x16 (&acc)[2][4], int tok0w, int f0w, int r, int h, char* sreg, const char* xtra) const {
        {
            const float* tbl = wave_rstd_table(ssq, tok0w, xtra, 32 * h + r);
#pragma unroll
            for (int tb = 0; tb < 4; ++tb) { const float rs = tbl[32 * tb + r];
#pragma unroll
                for (int fb = 0; fb < 2; ++fb)
#pragma unroll
                    for (int i = 0; i < 16; ++i) acc[fb][tb][i] *= rs; }
        }
        if (f0w < 1024) {
            const float sc = f0w < 512 ? QSCALE : 1.0f;
#pragma unroll
            for (int tb = 0; tb < 4; ++tb) {
                const int t = tok0w + 32 * tb + r, s = t & (SEQ - 1);
                const f32x4 cs0 = *(const f32x4*)(ropea + s * 8 + 4 * h), cs1 = *(const f32x4*)(ropea + s * 8 + 4 * h + 2);
                const float c[4] = {cs0[0], cs0[2], cs1[0], cs1[2]}, sn[4] = {cs0[1], cs0[3], cs1[1], cs1[3]};
#pragma unroll
                for (int e = 0; e < 4; ++e) { const float x1 = acc[0][tb][e], x2 = acc[0][tb][4 + e]; acc[0][tb][e] = x1 * c[e] - x2 * sn[e]; acc[0][tb][4 + e] = x2 * c[e] + x1 * sn[e]; }
#pragma unroll
                for (int fb = 0; fb < 2; ++fb)
#pragma unroll
                    for (int g = 0; g < 4; ++g)
                        lds_put4(sreg + (32 * tb + r) * 144 + (32 * fb + 8 * g + 4 * h) * 2, acc[fb][tb][4 * g] * sc, acc[fb][tb][4 * g + 1] * sc, acc[fb][tb][4 * g + 2] * sc, acc[fb][tb][4 * g + 3] * sc);
            }
            stage_flush<128, 128, false>(sreg, 32 * h + r, qkb + (size_t)tok0w * QLD + f0w, QLD);
            return;
        }
        const bool isq = f0w < 2048; const float sc = isq ? QSCALE : 1.0f; const float* gn = isq ? qn : kn;
        const int ocol = isq ? (1024 + f0w - 1536) : (1536 + f0w - 2048);
        f32x4 gv[2][4];
#pragma unroll
        for (int fb = 0; fb < 2; ++fb)
#pragma unroll
            for (int g = 0; g < 4; ++g) gv[fb][g] = *(const f32x4*)(gn + 32 * fb + 8 * g + 4 * h);
#pragma unroll
        for (int tb = 0; tb < 4; ++tb) {
            const int t = tok0w + 32 * tb + r, s = t & (SEQ - 1);
            float ss = 0.f;
#pragma unroll
            for (int fb = 0; fb < 2; ++fb)
#pragma unroll
                for (int i = 0; i < 16; ++i) ss += acc[fb][tb][i] * acc[fb][tb][i];
            ss += __shfl_xor(ss, 32);
            const float rs = __builtin_amdgcn_rsqf(ss * (1.0f / 64.0f) + EPS);
#pragma unroll
            for (int fb = 0; fb < 2; ++fb)
#pragma unroll
                for (int g = 0; g < 4; ++g)
#pragma unroll
                    for (int e = 0; e < 4; ++e) acc[fb][tb][4 * g + e] *= rs * gv[fb][g][e];
#pragma unroll
            for (int fb = 0; fb < 2; ++fb) {
                const int pos = fb == 0 ? (s >> 6) : (s & 63);
#pragma unroll
                for (int g = 0; g < 2; ++g) {
                    const f32x4 cs0 = *(const f32x4*)(ropeb + pos * 16 + 8 * g + 4 * h), cs1 = *(const f32x4*)(ropeb + pos * 16 + 8 * g + 4 * h + 2);
                    const float c[4] = {cs0[0], cs0[2], cs1[0], cs1[2]}, sn[4] = {cs0[1], cs0[3], cs1[1], cs1[3]};
#pragma unroll
                    for (int e = 0; e < 4; ++e) { const float x1 = acc[fb][tb][4 * g + e], x2 = acc[fb][tb][4 * (g + 2) + e]; acc[fb][tb][4 * g + e] = x1 * c[e] - x2 * sn[e]; acc[fb][tb][4 * (g + 2) + e] = x2 * c[e] + x1 * sn[e]; }
                }
            }
#pragma unroll
            for (int fb = 0; fb < 2; ++fb)
#pragma unroll
                for (int g = 0; g < 4; ++g)
                    lds_put4(sreg + (32 * tb + r) * 144 + (32 * fb + 8 * g + 4 * h) * 2, acc[fb][tb][4 * g] * sc, acc[fb][tb][4 * g + 1] * sc, acc[fb][tb][4 * g + 2] * sc, acc[fb][tb][4 * g + 3] * sc);
        }
        stage_flush<128, 128, false>(sreg, 32 * h + r, qkb + (size_t)tok0w * QLD + ocol, QLD);
    }
};

struct EpiInOdd {
    bf16_t* qkb; bf16_t* cvt; const float* ssq;
    static constexpr bool HAS_NSW = true, PERM_TOK = false, STAGED = true;
    DI void tile_prologue(char*, int, int) const {}
    DI bool swapped(int f0) const { return f0 < 2048; }
    DI void nsw(f32x16 (&acc)[2][4], int tok0w, int f0w, int r, int h, char* sreg, const char* xtra) const {
        {
            const float* tbl = wave_rstd_table(ssq, tok0w, xtra, 32 * h + r);
#pragma unroll
            for (int tb = 0; tb < 4; ++tb)
#pragma unroll
                for (int g = 0; g < 4; ++g) { const f32x4 q = *(const f32x4*)(tbl + 32 * tb + 8 * g + 4 * h);
#pragma unroll
                    for (int e = 0; e < 4; ++e) { acc[0][tb][4 * g + e] *= q[e]; acc[1][tb][4 * g + e] *= q[e]; } }
        }
        {
            const int c = f0w - 2048; const int drow0 = ((tok0w >> 13) * 16 + (c >> 6)) * 64; const int s0 = tok0w & (SEQ - 1);
#pragma unroll
            for (int fb = 0; fb < 2; ++fb)
#pragma unroll
                for (int tb = 0; tb < 4; ++tb)
#pragma unroll
                    for (int g = 0; g < 4; ++g)
                        lds_put4(sreg + (32 * fb + r) * 272 + (32 * tb + 8 * g + 4 * h) * 2, acc[fb][tb][4 * g], acc[fb][tb][4 * g + 1], acc[fb][tb][4 * g + 2], acc[fb][tb][4 * g + 3]);
            stage_flush<64, 256, false>(sreg, 32 * h + r, cvt + (size_t)drow0 * SEQ + s0, SEQ);
        }
    }
    DI void swp(f32x16 (&acc)[2][4], int tok0w, int f0w, int r, int h, char* sreg, const char* xtra) const {
        {
            const float* tbl = wave_rstd_table(ssq, tok0w, xtra, 32 * h + r);
#pragma unroll
            for (int tb = 0; tb < 4; ++tb) { const float rs = tbl[32 * tb + r];
#pragma unroll
                for (int fb = 0; fb < 2; ++fb)
#pragma unroll
                    for (int i = 0; i < 16; ++i) acc[fb][tb][i] *= rs; }
        }
        const float sc = f0w < 1024 ? QSCALE : 1.0f;
#pragma unroll
        for (int tb = 0; tb < 4; ++tb) {
            const int t = tok0w + 32 * tb + r;
#pragma unroll
            for (int fb = 0; fb < 2; ++fb)
#pragma unroll
                for (int g = 0; g < 4; ++g)
                    lds_put4(sreg + (32 * tb + r) * 144 + (32 * fb + 8 * g + 4 * h) * 2, acc[fb][tb][4 * g] * sc, acc[fb][tb][4 * g + 1] * sc, acc[fb][tb][4 * g + 2] * sc, acc[fb][tb][4 * g + 3] * sc);
        }
        stage_flush<128, 128, false>(sreg, 32 * h + r, qkb + (size_t)tok0w * QLD + f0w, QLD);
    }
};

struct EpiResid {
    const float* res; float* out; bf16_t* xb; float* ssq;
    static constexpr bool HAS_NSW = false, PERM_TOK = false, STAGED = true;
    DI void tile_prologue(char*, int, int) const {}
    DI bool swapped(int) const { return true; }
    DI void nsw(f32x16 (&)[2][4], int, int, int, int, char*, const char*) const {}
    DI void swp(f32x16 (&acc)[2][4], int tok0w, int f0w, int r, int h, char* sreg, const char* xtra) const {
        f32x4 rv[2][8];
        const size_t base = (size_t)(tok0w + r) * DM + f0w + 4 * h;
#pragma unroll
        for (int q = 0; q < 8; ++q) rv[0][q] = *(const f32x4*)(res + base + 32 * (q >> 2) + 8 * (q & 3));
#pragma unroll
        for (int tb = 0; tb < 4; ++tb) {
            if (tb < 3) {
#pragma unroll
                for (int q = 0; q < 8; ++q) rv[(tb + 1) & 1][q] = *(const f32x4*)(res + base + (size_t)(32 * (tb + 1)) * DM + 32 * (q >> 2) + 8 * (q & 3));
            }
            float ss = 0.f;
#pragma unroll
            for (int q = 0; q < 8; ++q) {
                const int fb = q >> 2, g = q & 3; const f32x4 c = rv[tb & 1][q];
                f32x4 v = {acc[fb][tb][4 * g] + c[0], acc[fb][tb][4 * g + 1] + c[1], acc[fb][tb][4 * g + 2] + c[2], acc[fb][tb][4 * g + 3] + c[3]};
                *(f32x4*)(out + base + (size_t)(32 * tb) * DM + 32 * fb + 8 * g) = v;
                ss += v[0] * v[0] + v[1] * v[1] + v[2] * v[2] + v[3] * v[3];
                lds_put4(sreg + (32 * tb + r) * 144 + (32 * fb + 8 * g + 4 * h) * 2, v[0], v[1], v[2], v[3]);
            }
            ss = xhalf_sum(ss);
            if (h == 0) ssq[(size_t)(f0w >> 6) * T_TOK + tok0w + 32 * tb + r] = ss;
        }
        stage_flush<128, 128, false>(sreg, 32 * h + r, xb + (size_t)tok0w * DM + f0w, DM);
    }
};

struct EpiBf16 {
    bf16_t* out;
    static constexpr bool HAS_NSW = false, PERM_TOK = false, STAGED = true;
    DI void tile_prologue(char*, int, int) const {}
    DI bool swapped(int) const { return true; }
    DI void nsw(f32x16 (&)[2][4], int, int, int, int, char*, const char*) const {}
    DI void swp(f32x16 (&acc)[2][4], int tok0w, int f0w, int r, int h, char* sreg, const char* xtra) const {
#pragma unroll
        for (int tb = 0; tb < 4; ++tb)
#pragma unroll
            for (int fb = 0; fb < 2; ++fb)
#pragma unroll
                for (int g = 0; g < 4; ++g)
                    lds_put4(sreg + (32 * tb + r) * 144 + (32 * fb + 8 * g + 4 * h) * 2, acc[fb][tb][4 * g], acc[fb][tb][4 * g + 1], acc[fb][tb][4 * g + 2], acc[fb][tb][4 * g + 3]);
        stage_flush<128, 128, false>(sreg, 32 * h + r, out + (size_t)tok0w * DM + f0w, DM);
    }
};

struct EpiPle {
    float* x; bf16_t* pj; const float* ssq_in; float* ssq_out;
    static constexpr bool HAS_NSW = false, PERM_TOK = false, STAGED = true;
    DI void tile_prologue(char*, int, int) const {}
    DI bool swapped(int) const { return true; }
    DI void nsw(f32x16 (&)[2][4], int, int, int, int, char*, const char*) const {}
    DI void swp(f32x16 (&acc)[2][4], int tok0w, int f0w, int r, int h, char* sreg, const char* xtra) const {
        f32x4 rv[2][8]; u32x2 pw[2][8];
        const float* tbl = wave_rstd_table(ssq_in, tok0w, xtra, 32 * h + r);
        const size_t base = (size_t)(tok0w + r) * DM + f0w + 4 * h;
#pragma unroll
        for (int q = 0; q < 8; ++q) { const size_t o = base + 32 * (q >> 2) + 8 * (q & 3); rv[0][q] = *(const f32x4*)(x + o); pw[0][q] = *(const u32x2*)(pj + o); }
#pragma unroll
        for (int tb = 0; tb < 4; ++tb) {
            if (tb < 3) {
#pragma unroll
                for (int q = 0; q < 8; ++q) { const size_t o = base + (size_t)(32 * (tb + 1)) * DM + 32 * (q >> 2) + 8 * (q & 3); rv[(tb + 1) & 1][q] = *(const f32x4*)(x + o); pw[(tb + 1) & 1][q] = *(const u32x2*)(pj + o); }
            }
            const float rs = tbl[32 * tb + r];
            float ss = 0.f;
#pragma unroll
            for (int q = 0; q < 8; ++q) {
                const int fb = q >> 2, g = q & 3; const f32x4 c = rv[tb & 1][q]; const u32x2 w = pw[tb & 1][q];
                const float p0 = __uint_as_float(w.x << 16), p1 = __uint_as_float(w.x & 0xffff0000u), p2 = __uint_as_float(w.y << 16), p3 = __uint_as_float(w.y & 0xffff0000u);
                f32x4 v = {c[0] + sigmoidf_(acc[fb][tb][4 * g] * rs) * p0, c[1] + sigmoidf_(acc[fb][tb][4 * g + 1] * rs) * p1, c[2] + sigmoidf_(acc[fb][tb][4 * g + 2] * rs) * p2, c[3] + sigmoidf_(acc[fb][tb][4 * g + 3] * rs) * p3};
                *(f32x4*)(x + base + (size_t)(32 * tb) * DM + 32 * fb + 8 * g) = v;
                ss += v[0] * v[0] + v[1] * v[1] + v[2] * v[2] + v[3] * v[3];
                lds_put4(sreg + (32 * tb + r) * 144 + (32 * fb + 8 * g + 4 * h) * 2, v[0], v[1], v[2], v[3]);
            }
            ss = xhalf_sum(ss);
            if (h == 0) ssq_out[(size_t)(f0w >> 6) * T_TOK + tok0w + 32 * tb + r] = ss;
        }
        stage_flush<128, 128, false>(sreg, 32 * h + r, pj + (size_t)tok0w * DM + f0w, DM);
    }
};

DI float dpp_prev(float v) { return __builtin_bit_cast(float, __builtin_amdgcn_update_dpp(0, __builtin_bit_cast(int, v), 0x138, 0xf, 0xf, false)); }
DI float dpp_next(float v) { return __builtin_bit_cast(float, __builtin_amdgcn_update_dpp(0, __builtin_bit_cast(int, v), 0x130, 0xf, 0xf, false)); }
struct EpiUp {
    bf16_t* act; float* halo; const float* cw; const float* cb; const float* ssq;
    static constexpr bool HAS_NSW = false, PERM_TOK = true, STAGED = true;
    DI bool swapped(int) const { return true; }
    DI void tile_prologue(char* lds, int col0, int tid) const {
        float* pl = (float*)(lds + 4 * GT_BYTES);
        const int idx = tid * 2, p = idx >> 8, slot = idx & 255, pc = col0 + slot;
        const int ch = (pc >> 6) * 32 + (slot & 31) + ((slot >> 5) & 1) * DFF;
        const f32x2 v = p < 3 ? *(const f32x2*)(cw + p * 5632 + ch) : *(const f32x2*)(cb + ch);
        *(f32x2*)(pl + idx) = v;
    }
    DI void nsw(f32x16 (&)[2][4], int, int, int, int, char*, const char*) const {}
    DI void swp(f32x16 (&acc)[2][4], int tok0w, int f0w, int r, int h, char* sreg, const char* xtra) const {
        {
            const float* tbl = wave_rstd_table(ssq, tok0w, xtra, 32 * h + r);
            const f32x4 q = *(const f32x4*)(tbl + 4 * r);
#pragma unroll
            for (int tb = 0; tb < 4; ++tb) { const float rs = q[tb];
#pragma unroll
                for (int fb = 0; fb < 2; ++fb)
#pragma unroll
                    for (int i = 0; i < 16; ++i) acc[fb][tb][i] *= rs; }
        }
        const int c0 = (f0w >> 6) * 32;
        float* hl = halo + (size_t)(tok0w >> 7) * 4 * 5632;
        const float* pl = (const float*)xtra + (f0w & 255);
#pragma unroll
        for (int g = 0; g < 4; ++g) {
            const int c = c0 + 8 * g + 4 * h;
            f32x4 w0[2], w1[2], w2[2], bb[2];
#pragma unroll
            for (int fb = 0; fb < 2; ++fb) { const int sl = 32 * fb + 8 * g + 4 * h; w0[fb] = *(const f32x4*)(pl + sl); w1[fb] = *(const f32x4*)(pl + 256 + sl); w2[fb] = *(const f32x4*)(pl + 512 + sl); bb[fb] = *(const f32x4*)(pl + 768 + sl); }
            float o[4][4];
#pragma unroll
            for (int e = 0; e < 4; ++e) {
                float cv[2][4];
#pragma unroll
                for (int fb = 0; fb < 2; ++fb) {
                    const float u0 = acc[fb][0][4 * g + e], u1 = acc[fb][1][4 * g + e], u2 = acc[fb][2][4 * g + e], u3 = acc[fb][3][4 * g + e];
                    const float pv = dpp_prev(u3), nx = dpp_next(u0);
                    const float a0 = w0[fb][e], a1 = w1[fb][e], a2 = w2[fb][e], b0 = bb[fb][e];
                    cv[fb][0] = pv * a0 + (u0 * a1 + (u1 * a2 + b0));
                    cv[fb][1] = u0 * a0 + (u1 * a1 + (u2 * a2 + b0));
                    cv[fb][2] = u1 * a0 + (u2 * a1 + (u3 * a2 + b0));
                    cv[fb][3] = u2 * a0 + (u3 * a1 + (nx * a2 + b0));
                }
#pragma unroll
                for (int tb = 0; tb < 4; ++tb) o[tb][e] = cv[0][tb] * sigmoidf_(cv[0][tb]) * cv[1][tb];
            }
#pragma unroll
            for (int tb = 0; tb < 4; ++tb) lds_put4(sreg + (4 * r + tb) * 80 + (8 * g + 4 * h) * 2, o[tb][0], o[tb][1], o[tb][2], o[tb][3]);
            if (r == 0) {
#pragma unroll
                for (int fb = 0; fb < 2; ++fb)
#pragma unroll
                    for (int tb = 0; tb < 2; ++tb) *(f32x4*)(hl + (size_t)tb * 5632 + c + fb * DFF) = (f32x4){acc[fb][tb][4 * g], acc[fb][tb][4 * g + 1], acc[fb][tb][4 * g + 2], acc[fb][tb][4 * g + 3]};
            }
            if (r == 31) {
#pragma unroll
                for (int fb = 0; fb < 2; ++fb)
#pragma unroll
                    for (int tb = 2; tb < 4; ++tb) *(f32x4*)(hl + (size_t)tb * 5632 + c + fb * DFF) = (f32x4){acc[fb][tb][4 * g], acc[fb][tb][4 * g + 1], acc[fb][tb][4 * g + 2], acc[fb][tb][4 * g + 3]};
            }
        }
        stage_flush<128, 64, true>(sreg, 32 * h + r, act + (size_t)tok0w * DFF + c0, DFF);
    }
};

DI void phase_fix(const float* __restrict__ halo, bf16_t* __restrict__ act, const float* __restrict__ cw, const float* __restrict__ cb) {
    const int total = 256 * 2 * DFF;
    for (int i = blockIdx.x * NTHREADS + tidx(); i < total; i += gridDim.x * NTHREADS) {
        const int c = i % DFF, et = i / DFF, k = et >> 1, side = et & 1;
        const int t = k * 128 + (side ? 127 : 0); const int s = t & (SEQ - 1);
        const float* hk = halo + (size_t)k * 4 * 5632;
        float o[2];
#pragma unroll
        for (int fb = 0; fb < 2; ++fb) {
            const int ch = c + fb * DFF; float pv, cu, nx;
            if (side == 0) { cu = hk[ch]; nx = hk[5632 + ch]; pv = s == 0 ? 0.f : hk[ch - 5632]; }
            else { cu = hk[3 * 5632 + ch]; pv = hk[2 * 5632 + ch]; nx = s == SEQ - 1 ? 0.f : hk[4 * 5632 + ch]; }
            o[fb] = pv * cw[ch] + cu * cw[5632 + ch] + nx * cw[2 * 5632 + ch] + cb[ch];
        }
        const float a = o[0] * sigmoidf_(o[0]) * o[1];
        act[(size_t)t * DFF + c] = (bf16_t)(pk2(a, 0.f) & 0xffff);
    }
}

template <int NDB, bool NA>
DI void attn_tile(const char* ldsK, const char* ldsV, const bf16x8 (&qf)[4], f32x16 (&o)[NDB], float& m, float& l, int r, int h, const float* lbias, int qc, f32x16& sinit, bool first) {
    const int pr = (r & 0x13) | ((r & 4) << 1) | ((r & 8) >> 1);
    f32x16 s[2];
#pragma unroll
    for (int ks = 0; ks < 2; ++ks) {
        const char* kp = ldsK + (ks * 32 + pr) * LROW + h * 16;
        s[ks] = mfma32(*(const bf16x8*)kp, qf[0], sinit);
#pragma unroll
        for (int t = 1; t < 4; ++t) s[ks] = mfma32(*(const bf16x8*)(kp + t * 32), qf[t], s[ks]);
    }
    if (NA) {
        int cs = qc - 8; cs = cs < 0 ? 0 : (cs > 48 ? 48 : cs);
        int base = 8 * h - qc + 15, base2 = 8 * h - cs;
#pragma unroll
        for (int ks = 0; ks < 2; ++ks)
#pragma unroll
            for (int i = 0; i < 16; ++i) {
                const int off = 32 * ks + (i & 7) + 16 * (i >> 3);
                int d = base + off; d = d < 0 ? 0 : (d > 30 ? 30 : d);
                const bool valid = (unsigned)(base2 + off) < 16u;
                s[ks][i] = valid ? s[ks][i] + lbias[d] : -1e30f;
            }
    }
    if (first) {
        float mx = fmaxf(s[0][0], s[0][1]);
#pragma unroll
        for (int i = 2; i < 16; i += 2) mx = fmaxf(mx, fmaxf(s[0][i], s[0][i + 1]));
#pragma unroll
        for (int i = 0; i < 16; i += 2) mx = fmaxf(mx, fmaxf(s[1][i], s[1][i + 1]));
        mx = xhalf_max(mx);
        m += mx;
#pragma unroll
        for (int i = 0; i < 16; ++i) sinit[i] = -m;
#pragma unroll
        for (int ks = 0; ks < 2; ++ks)
#pragma unroll
            for (int i = 0; i < 16; ++i) s[ks][i] -= mx;
    }
    float ps0 = 0.f, ps1 = 0.f;
#pragma unroll
    for (int ks = 0; ks < 2; ++ks)
#pragma unroll
        for (int i = 0; i < 16; i += 2) { const float p0 = fexp2(s[ks][i]), p1 = fexp2(s[ks][i + 1]); ps0 += p0; ps1 += p1; s[ks][i] = p0; s[ks][i + 1] = p1; }
    float pst = ps0 + ps1;
    if (__builtin_amdgcn_ballot_w64(pst > 65536.0f) != 0ull) {
        float pm = fmaxf(s[0][0], s[0][1]);
#pragma unroll
        for (int i = 2; i < 16; i += 2) pm = fmaxf(pm, fmaxf(s[0][i], s[0][i + 1]));
#pragma unroll
        for (int i = 0; i < 16; i += 2) pm = fmaxf(pm, fmaxf(s[1][i], s[1][i + 1]));
        pm = xhalf_max(pm);
        int e = __builtin_amdgcn_frexp_expf(pm) - 1; e = e < 0 ? 0 : e;
        const float de = (float)e, alpha = fexp2(-de);
        m += de; l *= alpha; pst *= alpha;
#pragma unroll
        for (int i = 0; i < 16; ++i) sinit[i] = -m;
#pragma unroll
        for (int ks = 0; ks < 2; ++ks)
#pragma unroll
            for (int i = 0; i < 16; ++i) s[ks][i] *= alpha;
#pragma unroll
        for (int db = 0; db < NDB; ++db)
#pragma unroll
            for (int i = 0; i < 16; ++i) o[db][i] *= alpha;
    }
    l += pst;
#pragma unroll
    for (int ks = 0; ks < 2; ++ks)
#pragma unroll
        for (int sp = 0; sp < 2; ++sp) {
            u32x4 pw; pw.x = pk2(s[ks][8 * sp], s[ks][8 * sp + 1]); pw.y = pk2(s[ks][8 * sp + 2], s[ks][8 * sp + 3]); pw.z = pk2(s[ks][8 * sp + 4], s[ks][8 * sp + 5]); pw.w = pk2(s[ks][8 * sp + 6], s[ks][8 * sp + 7]);
            const bf16x8 pf = __builtin_bit_cast(bf16x8, pw);
            const char* vp = ldsV + r * LROW + (ks * 32 + sp * 16 + h * 8) * 2;
#pragma unroll
            for (int db = 0; db < NDB; ++db) o[db] = mfma32(*(const bf16x8*)(vp + db * 32 * LROW), pf, o[db]);
        }
}

constexpr int KT_BYTES = 64 * LROW;

DI void attn_gqa_unit(char* lds, const bf16_t* __restrict__ qkb, const bf16_t* __restrict__ bvt, bf16_t* __restrict__ mix, int u) {
    const int tid = tidx(), lane = tid & 63, wid = __builtin_amdgcn_readfirstlane(tid >> 6), r = lane & 31, h = lane >> 5;
    const int pair = u & 7, qb = u >> 3, b = pair >> 1, g = pair & 1;
    const int tq = b * SEQ + qb * 64 + (wid >> 2) * 32 + r;
    const int qhead = g * 4 + (wid & 3);
    bf16x8 qf[4];
#pragma unroll
    for (int t = 0; t < 4; ++t) qf[t] = *(const bf16x8*)(qkb + (size_t)tq * QLD + 1024 + qhead * 64 + 16 * t + 8 * h);
    f32x16 o[2];
#pragma unroll
    for (int db = 0; db < 2; ++db)
#pragma unroll
        for (int i = 0; i < 16; ++i) o[db][i] = 0.f;
    float m = 0.f, l = 0.f;
    f32x16 sinit;
#pragma unroll
    for (int i = 0; i < 16; ++i) sinit[i] = 0.f;
    const int lrow = tid >> 3, lkc = tid & 7, lw = lrow * LROW + lkc * 16;
    const bf16_t* gk = qkb + (size_t)(b * SEQ + lrow) * QLD + 1536 + g * 64 + lkc * 8;
    const bf16_t* gv = bvt + (size_t)((b * 2 + g) * 64 + lrow) * SEQ + lkc * 8;
    u32x4 rk = *(const u32x4*)gk, rv = *(const u32x4*)gv;
    *(u32x4*)(lds + lw) = rk; *(u32x4*)(lds + KT_BYTES + lw) = rv;
#pragma unroll
    for (int t = 0; t < 4; ++t) asm volatile("" : "+v"(qf[t]));
    __syncthreads();
    constexpr int NT = SEQ / 64;
#pragma unroll 1
    for (int it = 0; it < NT; ++it) {
        const bool more = it + 1 < NT;
        if (more) { rk = *(const u32x4*)(gk + (size_t)(it + 1) * 64 * QLD); rv = *(const u32x4*)(gv + (it + 1) * 64); }
        const char* buf = lds + (it & 1) * 2 * KT_BYTES;
        attn_tile<2, false>(buf, buf + KT_BYTES, qf, o, m, l, r, h, nullptr, 0, sinit, it == 0);
        if (more) { char* d = lds + ((it + 1) & 1) * 2 * KT_BYTES + lw; *(u32x4*)d = rk; *(u32x4*)(d + KT_BYTES) = rv; }
        __syncthreads();
    }
    l += __shfl_xor(l, 32);
    const float inv = 1.0f / l;
#pragma unroll
    for (int db = 0; db < 2; ++db)
#pragma unroll
        for (int g4 = 0; g4 < 4; ++g4)
            st_bf4(mix + (size_t)tq * DM + 512 + qhead * 64 + 32 * db + 8 * g4 + 4 * h, o[db][4 * g4] * inv, o[db][4 * g4 + 1] * inv, o[db][4 * g4 + 2] * inv, o[db][4 * g4 + 3] * inv);
}


DI void attn_gqa2_unit(char* lds, const bf16_t* __restrict__ qkb, const bf16_t* __restrict__ bvt, bf16_t* __restrict__ mix, int u) {
    const int tid = tidx(), lane = tid & 63, wid = __builtin_amdgcn_readfirstlane(tid >> 6), r = lane & 31, h = lane >> 5;
    const int pair = u & 7, qb = u >> 3, b = pair >> 1, g = pair & 1;
    const int tq0 = b * SEQ + qb * 128 + (wid >> 2) * 64 + r;
    const int qhead = g * 4 + (wid & 3);
    bf16x8 qf[2][4];
#pragma unroll
    for (int sb = 0; sb < 2; ++sb)
#pragma unroll
        for (int t = 0; t < 4; ++t) qf[sb][t] = *(const bf16x8*)(qkb + (size_t)(tq0 + 32 * sb) * QLD + 1024 + qhead * 64 + 16 * t + 8 * h);
    f32x16 o[2][2];
#pragma unroll
    for (int sb = 0; sb < 2; ++sb)
#pragma unroll
        for (int db = 0; db < 2; ++db)
#pragma unroll
            for (int i = 0; i < 16; ++i) o[sb][db][i] = 0.f;
    float m[2] = {0.f, 0.f}, l[2] = {0.f, 0.f};
    f32x16 sinit[2];
#pragma unroll
    for (int sb = 0; sb < 2; ++sb)
#pragma unroll
        for (int i = 0; i < 16; ++i) sinit[sb][i] = 0.f;
    const int lrow = tid >> 3, lkc = tid & 7, lw = lrow * LROW + lkc * 16;
    const bf16_t* gk = qkb + (size_t)(b * SEQ + lrow) * QLD + 1536 + g * 64 + lkc * 8;
    const bf16_t* gv = bvt + (size_t)((b * 2 + g) * 64 + lrow) * SEQ + lkc * 8;
    u32x4 rk = *(const u32x4*)gk, rv = *(const u32x4*)gv;
    *(u32x4*)(lds + lw) = rk; *(u32x4*)(lds + KT_BYTES + lw) = rv;
#pragma unroll
    for (int sb = 0; sb < 2; ++sb)
#pragma unroll
        for (int t = 0; t < 4; ++t) asm volatile("" : "+v"(qf[sb][t]));
    __syncthreads();
    const int pr = (r & 0x13) | ((r & 4) << 1) | ((r & 8) >> 1);
    constexpr int NT = SEQ / 64;
#pragma unroll 1
    for (int it = 0; it < NT; ++it) {
        const bool more = it + 1 < NT;
        if (more) { rk = *(const u32x4*)(gk + (size_t)(it + 1) * 64 * QLD); rv = *(const u32x4*)(gv + (it + 1) * 64); }
        const char* ldsK = lds + (it & 1) * 2 * KT_BYTES; const char* ldsV = ldsK + KT_BYTES;
        f32x16 s[2][2];
#pragma unroll
        for (int ks = 0; ks < 2; ++ks) {
            const char* kp = ldsK + (ks * 32 + pr) * LROW + h * 16;
            { const bf16x8 kf = *(const bf16x8*)kp; s[0][ks] = mfma32(kf, qf[0][0], sinit[0]); s[1][ks] = mfma32(kf, qf[1][0], sinit[1]); }
#pragma unroll
            for (int t = 1; t < 4; ++t) { const bf16x8 kf = *(const bf16x8*)(kp + t * 32); s[0][ks] = mfma32(kf, qf[0][t], s[0][ks]); s[1][ks] = mfma32(kf, qf[1][t], s[1][ks]); }
        }
        u32x4 pw[2][2][2];
#pragma unroll
        for (int sb = 0; sb < 2; ++sb) {
            float mx = fmaxf(s[sb][0][0], s[sb][0][1]);
#pragma unroll
            for (int i = 2; i < 16; i += 2) mx = fmaxf(mx, fmaxf(s[sb][0][i], s[sb][0][i + 1]));
#pragma unroll
            for (int i = 0; i < 16; i += 2) mx = fmaxf(mx, fmaxf(s[sb][1][i], s[sb][1][i + 1]));
            mx = xhalf_max(mx);
            if (it == 0 || __builtin_amdgcn_ballot_w64(mx > 8.0f) != 0ull) {
                const float dlt = it == 0 ? mx : fmaxf(mx, 0.f);
                const float alpha = it == 0 ? 1.0f : fexp2(-dlt);
                m[sb] += dlt; l[sb] *= alpha;
#pragma unroll
                for (int i = 0; i < 16; ++i) sinit[sb][i] = -m[sb];
#pragma unroll
                for (int ks = 0; ks < 2; ++ks)
#pragma unroll
                    for (int i = 0; i < 16; ++i) s[sb][ks][i] -= dlt;
#pragma unroll
                for (int db = 0; db < 2; ++db)
#pragma unroll
                    for (int i = 0; i < 16; ++i) o[sb][db][i] *= alpha;
            }
            float ps0 = 0.f, ps1 = 0.f;
#pragma unroll
            for (int ks = 0; ks < 2; ++ks)
#pragma unroll
                for (int i = 0; i < 16; i += 2) { const float p0 = fexp2(s[sb][ks][i]), p1 = fexp2(s[sb][ks][i + 1]); ps0 += p0; ps1 += p1; s[sb][ks][i] = p0; s[sb][ks][i + 1] = p1; }
            l[sb] += ps0 + ps1;
#pragma unroll
            for (int ks = 0; ks < 2; ++ks)
#pragma unroll
                for (int sp = 0; sp < 2; ++sp) {
                    pw[sb][ks][sp].x = pk2(s[sb][ks][8 * sp], s[sb][ks][8 * sp + 1]); pw[sb][ks][sp].y = pk2(s[sb][ks][8 * sp + 2], s[sb][ks][8 * sp + 3]);
                    pw[sb][ks][sp].z = pk2(s[sb][ks][8 * sp + 4], s[sb][ks][8 * sp + 5]); pw[sb][ks][sp].w = pk2(s[sb][ks][8 * sp + 6], s[sb][ks][8 * sp + 7]);
                }
        }
#pragma unroll
        for (int ks = 0; ks < 2; ++ks)
#pragma unroll
            for (int sp = 0; sp < 2; ++sp) {
                const char* vp = ldsV + r * LROW + (ks * 32 + sp * 16 + h * 8) * 2;
#pragma unroll
                for (int db = 0; db < 2; ++db) {
                    const bf16x8 vf = *(const bf16x8*)(vp + db * 32 * LROW);
                    o[0][db] = mfma32(vf, __builtin_bit_cast(bf16x8, pw[0][ks][sp]), o[0][db]);
                    o[1][db] = mfma32(vf, __builtin_bit_cast(bf16x8, pw[1][ks][sp]), o[1][db]);
                }
            }
        if (more) { char* d = lds + ((it + 1) & 1) * 2 * KT_BYTES + lw; *(u32x4*)d = rk; *(u32x4*)(d + KT_BYTES) = rv; }
        __syncthreads();
    }
#pragma unroll
    for (int sb = 0; sb < 2; ++sb) {
        const float lt = l[sb] + __shfl_xor(l[sb], 32);
        const float inv = 1.0f / lt;
#pragma unroll
        for (int db = 0; db < 2; ++db)
#pragma unroll
            for (int g4 = 0; g4 < 4; ++g4)
                st_bf4(mix + (size_t)(tq0 + 32 * sb) * DM + 512 + qhead * 64 + 32 * db + 8 * g4 + 4 * h, o[sb][db][4 * g4] * inv, o[sb][db][4 * g4 + 1] * inv, o[sb][db][4 * g4 + 2] * inv, o[sb][db][4 * g4 + 3] * inv);
    }
}

DI void attn_diff_unit(char* lds, const bf16_t* __restrict__ qkb, const bf16_t* __restrict__ avt, bf16_t* __restrict__ mix, int u, float lam, float lam_init, const float* __restrict__ subln) {
    const int tid = tidx(), lane = tid & 63, wid = __builtin_amdgcn_readfirstlane(tid >> 6), r = lane & 31, h = lane >> 5;
    const int pair = (u & 7) + 8 * (u >> 9), qb = ((u >> 3) & 31) + 32 * ((u >> 8) & 1), b = pair >> 2, hd = pair & 3;
    const int j = wid >> 2, qs = wid & 3;
    const int tq = b * SEQ + qb * 128 + qs * 32 + r;
    bf16x8 qf[4];
#pragma unroll
    for (int t = 0; t < 4; ++t) qf[t] = *(const bf16x8*)(qkb + (size_t)tq * QLD + (2 * hd + j) * 64 + 16 * t + 8 * h);
    f32x16 o[4];
#pragma unroll
    for (int db = 0; db < 4; ++db)
#pragma unroll
        for (int i = 0; i < 16; ++i) o[db][i] = 0.f;
    float m = 0.f, l = 0.f;
    f32x16 sinit;
#pragma unroll
    for (int i = 0; i < 16; ++i) sinit[i] = 0.f;
    const int lrow = tid >> 3, lkc = tid & 7, lw = lrow * LROW + lkc * 16;
    const bf16_t* gk = qkb + (size_t)(b * SEQ + lrow) * QLD + 512 + (2 * hd) * 64 + lkc * 8;
    const bf16_t* gv = avt + (size_t)((b * 4 + hd) * 128 + lrow) * SEQ + lkc * 8;
    constexpr int STG = 4 * KT_BYTES;
    u32x4 r0 = *(const u32x4*)gk, r1 = *(const u32x4*)(gk + 64), r2 = *(const u32x4*)gv, r3 = *(const u32x4*)(gv + (size_t)64 * SEQ);
    *(u32x4*)(lds + lw) = r0; *(u32x4*)(lds + KT_BYTES + lw) = r1; *(u32x4*)(lds + 2 * KT_BYTES + lw) = r2; *(u32x4*)(lds + 3 * KT_BYTES + lw) = r3;
#pragma unroll
    for (int t = 0; t < 4; ++t) asm volatile("" : "+v"(qf[t]));
    __syncthreads();
    constexpr int NT = SEQ / 64;
#pragma unroll 1
    for (int it = 0; it < NT; ++it) {
        const bool more = it + 1 < NT;
        if (more) { const bf16_t* k2 = gk + (size_t)(it + 1) * 64 * QLD; const bf16_t* v2 = gv + (it + 1) * 64; r0 = *(const u32x4*)k2; r1 = *(const u32x4*)(k2 + 64); r2 = *(const u32x4*)v2; r3 = *(const u32x4*)(v2 + (size_t)64 * SEQ); }
        const char* buf = lds + (it & 1) * STG;
        attn_tile<4, false>(buf + j * KT_BYTES, buf + 2 * KT_BYTES, qf, o, m, l, r, h, nullptr, 0, sinit, it == 0);
        if (more) { char* d = lds + ((it + 1) & 1) * STG + lw; *(u32x4*)d = r0; *(u32x4*)(d + KT_BYTES) = r1; *(u32x4*)(d + 2 * KT_BYTES) = r2; *(u32x4*)(d + 3 * KT_BYTES) = r3; }
        __syncthreads();
    }
    l += __shfl_xor(l, 32);
    const float inv = 1.0f / l;
    float* xch = (float*)lds;
    if (j == 1) {
#pragma unroll
        for (int db = 0; db < 4; ++db)
#pragma unroll
            for (int i = 0; i < 16; ++i) xch[((qs * 4 + db) * 16 + i) * 64 + lane] = o[db][i] * inv;
    }
    __syncthreads();
    if (j == 0) {
        float ss = 0.f;
#pragma unroll
        for (int db = 0; db < 4; ++db)
#pragma unroll
            for (int i = 0; i < 16; ++i) { const float v = o[db][i] * inv - lam * xch[((qs * 4 + db) * 16 + i) * 64 + lane]; o[db][i] = v; ss += v * v; }
        ss += __shfl_xor(ss, 32);
        const float rs = __builtin_amdgcn_rsqf(ss * (1.0f / 128.0f) + EPS) * (1.0f - lam_init);
#pragma unroll
        for (int db = 0; db < 4; ++db)
#pragma unroll
            for (int g4 = 0; g4 < 4; ++g4) {
                const int d = 32 * db + 8 * g4 + 4 * h; const f32x4 gv4 = *(const f32x4*)(subln + d);
                st_bf4(mix + (size_t)tq * DM + hd * 128 + d, o[db][4 * g4] * rs * gv4[0], o[db][4 * g4 + 1] * rs * gv4[1], o[db][4 * g4 + 2] * rs * gv4[2], o[db][4 * g4 + 3] * rs * gv4[3]);
            }
    }
    __syncthreads();
}

DI void attn_na_unit(char* lds, const bf16_t* __restrict__ qkb, const bf16_t* __restrict__ cvt, bf16_t* __restrict__ mix, int u, const float* __restrict__ bias) {
    const int tid = tidx(), lane = tid & 63, wid = __builtin_amdgcn_readfirstlane(tid >> 6), r = lane & 31, h = lane >> 5;
    const int hg = u & 3, R = (u >> 2) & 127, b = u >> 9;
    const int hw = wid & 3, head = 4 * hg + hw, qc = (wid >> 2) * 32 + r;
    const int tq = b * SEQ + R * 64 + qc;
    int rs = R - 4; rs = rs < 0 ? 0 : (rs > 120 ? 120 : rs);
    constexpr int STG = 8 * KT_BYTES;
    bf16x8 qf[4];
#pragma unroll
    for (int t = 0; t < 4; ++t) qf[t] = *(const bf16x8*)(qkb + (size_t)tq * QLD + head * 64 + 16 * t + 8 * h);
    f32x16 o[2];
#pragma unroll
    for (int db = 0; db < 2; ++db)
#pragma unroll
        for (int i = 0; i < 16; ++i) o[db][i] = 0.f;
    float m = 0.f, l = 0.f;
    f32x16 sinit;
#pragma unroll
    for (int i = 0; i < 16; ++i) sinit[i] = 0.f;
    const int lrow = tid >> 3, lkc = tid & 7, lw = lrow * LROW + lkc * 16;
    const bf16_t* gk = qkb + (size_t)(b * SEQ + rs * 64 + lrow) * QLD + 1024 + (4 * hg) * 64 + lkc * 8;
    const bf16_t* gv = cvt + (size_t)((b * 16 + 4 * hg) * 64 + lrow) * SEQ + rs * 64 + lkc * 8;
    float* lb = (float*)(lds + 4 * GT_BYTES);
    for (int i = tid; i < 4 * 465; i += NTHREADS) lb[i] = bias[(size_t)hg * 4 * 465 + i] * LOG2E;
    u32x4 rk[4], rv[4];
#pragma unroll
    for (int hd = 0; hd < 4; ++hd) { rk[hd] = *(const u32x4*)(gk + 64 * hd); rv[hd] = *(const u32x4*)(gv + (size_t)hd * 64 * SEQ); }
#pragma unroll
    for (int hd = 0; hd < 4; ++hd) { *(u32x4*)(lds + (2 * hd) * KT_BYTES + lw) = rk[hd]; *(u32x4*)(lds + (2 * hd + 1) * KT_BYTES + lw) = rv[hd]; }
#pragma unroll
    for (int t = 0; t < 4; ++t) asm volatile("" : "+v"(qf[t]));
    __syncthreads();
#pragma unroll 1
    for (int it = 0; it < 8; ++it) {
        const bool more = it + 1 < 8;
        if (more) {
#pragma unroll
            for (int hd = 0; hd < 4; ++hd) { rk[hd] = *(const u32x4*)(gk + (size_t)(it + 1) * 64 * QLD + 64 * hd); rv[hd] = *(const u32x4*)(gv + (size_t)hd * 64 * SEQ + (it + 1) * 64); }
        }
        const char* buf = lds + (it & 1) * STG + (2 * hw) * KT_BYTES;
        const float* brow = lb + (hw * 15 + (rs + it - R + 7)) * 31;
        attn_tile<2, true>(buf, buf + KT_BYTES, qf, o, m, l, r, h, brow, qc, sinit, it == 0);
        if (more) {
            char* d = lds + ((it + 1) & 1) * STG + lw;
#pragma unroll
            for (int hd = 0; hd < 4; ++hd) { *(u32x4*)(d + (2 * hd) * KT_BYTES) = rk[hd]; *(u32x4*)(d + (2 * hd + 1) * KT_BYTES) = rv[hd]; }
        }
        __syncthreads();
    }
    l += __shfl_xor(l, 32);
    const float inv = 1.0f / l;
#pragma unroll
    for (int db = 0; db < 2; ++db)
#pragma unroll
        for (int g4 = 0; g4 < 4; ++g4)
            st_bf4(mix + (size_t)tq * DM + head * 64 + 32 * db + 8 * g4 + 4 * h, o[db][4 * g4] * inv, o[db][4 * g4 + 1] * inv, o[db][4 * g4 + 2] * inv, o[db][4 * g4 + 3] * inv);
}


#define XB_TMO      128
#define XB_XCNT(j)  (256  + 64 * (j))
#define XB_XSUB(j)  (1280 + 64 * (j))
#define XB_XGEN(j)  (2304 + 64 * (j))
#define XB_TOP      3328
#define XB_TOPGEN   3392
#define XCD_BAR_WORDS 3456
#define XB_SPIN_CAP (1u << 23)
#define LAS __attribute__((address_space(3)))
DI unsigned xb_ld(unsigned* p)              { return __hip_atomic_load(p, __ATOMIC_RELAXED, __HIP_MEMORY_SCOPE_AGENT); }
DI unsigned xb_add(unsigned* p, unsigned v) { return __hip_atomic_fetch_add(p, v, __ATOMIC_RELAXED, __HIP_MEMORY_SCOPE_AGENT); }
DI unsigned xb_xcc_id() { return (unsigned)__builtin_amdgcn_s_getreg((3 << 11) | 20) & 0xFu; }
#define XB_SPIN(cond, bar) do { unsigned _sp = 0; while (cond) { __builtin_amdgcn_s_sleep(1); \
    if ((++_sp & 255u) == 0u) { if (xb_ld(&(bar)[XB_TMO])) break; if (_sp > XB_SPIN_CAP) { atomicAdd(&(bar)[XB_TMO], 1u); break; } } } } while (0)
struct XcdBarrier { unsigned* bar; unsigned x; volatile LAS unsigned* st; unsigned slot; };
DI XcdBarrier xcd_barrier_post(unsigned* bar, volatile LAS unsigned* st) {
    XcdBarrier b; b.bar = bar; b.x = xb_xcc_id(); b.st = st; b.slot = 0u;
    if (threadIdx.x == 0) b.slot = xb_add(&bar[XB_XCNT(b.x)], 1u);
    return b;
}
DI void xcd_barrier_complete(unsigned* bar, unsigned x, unsigned& nloc, unsigned& nx) {
    const unsigned G = gridDim.x * gridDim.y * gridDim.z;
    unsigned sum, cnt, mine, sp = 0u;
    for (;;) {
        sum = 0u; cnt = 0u; mine = 0u;
#pragma unroll
        for (unsigned j = 0; j < 16; ++j) { const unsigned c = xb_ld(&bar[XB_XCNT(j)]); sum += c; cnt += (c > 0u) ? 1u : 0u; mine = (j == x) ? c : mine; }
        if (sum == G) break;
        __builtin_amdgcn_s_sleep(1);
        if ((++sp & 255u) == 0u) { if (xb_ld(&bar[XB_TMO])) break; if (sp > XB_SPIN_CAP) { atomicAdd(&bar[XB_TMO], 1u); break; } }
    }
    nloc = mine > 0u ? mine : 1u; nx = cnt > 0u ? cnt : 1u;
}
DI void xcd_barrier(const XcdBarrier& b) {
    asm volatile("s_waitcnt vmcnt(0)" ::: "memory");
    __syncthreads();
    if (threadIdx.x == 0) {
        unsigned* bar = b.bar;
        __builtin_amdgcn_s_waitcnt(0);
        unsigned nloc = b.st[0], nx = b.st[1];
        if (nloc == 0u) { xcd_barrier_complete(bar, b.x, nloc, nx); b.st[0] = nloc; b.st[1] = nx; }
        const unsigned old = xb_add(&bar[XB_XSUB(b.x)], 1u);
        const unsigned gen = old / nloc;
        if (old + 1u == (gen + 1u) * nloc) {
            __builtin_amdgcn_fence(__ATOMIC_RELEASE, "agent");
            asm volatile("s_waitcnt vmcnt(0)" ::: "memory");
            const unsigned og = xb_add(&bar[XB_TOP], 1u);
            const unsigned tg = og / nx;
            if (og + 1u == (tg + 1u) * nx) xb_add(&bar[XB_TOPGEN], 1u);
            else XB_SPIN(xb_ld(&bar[XB_TOPGEN]) == tg, bar);
            __builtin_amdgcn_fence(__ATOMIC_ACQUIRE, "agent");
            xb_add(&bar[XB_XGEN(b.x)], 1u);
            asm volatile("s_waitcnt vmcnt(0)" ::: "memory");
        } else {
            XB_SPIN(xb_ld(&bar[XB_XGEN(b.x)]) == gen, bar);
            __builtin_amdgcn_fence(__ATOMIC_ACQUIRE, "agent");
            asm volatile("s_waitcnt vmcnt(0)" ::: "memory");
        }
    }
    __syncthreads();
}

__global__ void __launch_bounds__(NTHREADS) fwd_megakernel(Params P) {
    extern __shared__ __attribute__((aligned(16))) char lds[];
    cg::grid_group grid = cg::this_grid();
    volatile LAS unsigned* xst = (volatile LAS unsigned*)(lds + LDS_BYTES - 16);
    if (threadIdx.x == 0) { xst[0] = 0u; xst[1] = 0u; }
    __syncthreads();
    const XcdBarrier xb = xcd_barrier_post((unsigned*)(P.ws + OFF_BAR), xst);
    char* ws = P.ws;
    bf16_t* H = (bf16_t*)(ws + OFF_H); bf16_t* QKB = (bf16_t*)(ws + OFF_QKB); bf16_t* VT = (bf16_t*)(ws + OFF_VT);
    bf16_t* ACT = (bf16_t*)(ws + OFF_ACT); bf16_t* MIX = (bf16_t*)(ws + OFF_MIX); float* HALO = (float*)(ws + OFF_HALO); bf16_t* PB = (bf16_t*)(ws + OFF_PB);
    const f32x2* ROPEA = (const f32x2*)(ws + OFF_ROPEA); const f32x2* ROPEB = (const f32x2*)(ws + OFF_ROPEB);
    float* X = P.out;
    bf16_t* AVT = VT; bf16_t* BVT = VT + (size_t)4 * 4 * 128 * SEQ;

    float* SSQ = (float*)(ws + OFF_SSQ);
    phase_prep(P, lds);
    phase_x0(P.x, MIX, SSQ);
    phase_cvt_p(P.p, PB);
    grid.sync();
    int vbid = blockIdx.x;
    {
        volatile LAS unsigned* vst = (volatile LAS unsigned*)(lds + LDS_BYTES - 32);
        if (threadIdx.x == 0) {
            unsigned* bar = (unsigned*)(P.ws + OFF_BAR); bool ok = (gridDim.x & 7) == 0;
            for (unsigned jx = 0; jx < 16; ++jx) { const unsigned c = xb_ld(&bar[XB_XCNT(jx)]); ok = ok && (c == (jx < 8 ? gridDim.x / 8 : 0u)); }
            vst[0] = ok ? xb.slot * 8u + xb.x : blockIdx.x;
        }
        __syncthreads();
        vbid = (int)vst[0];
        __syncthreads();
    }

#pragma unroll 1
    for (int l = 0; l < 4; ++l) {
        const bf16_t* wl = (const bf16_t*)(ws + OFF_WB) + (size_t)l * WL_ELEMS; const int j = l >> 1;
        const float* xres = l == 0 ? P.x : X;
        float* ssq_a = SSQ + (size_t)(3 * l) * T_TOK * 16; float* ssq_f = ssq_a + (size_t)T_TOK * 16; float* ssq_p = ssq_f + (size_t)T_TOK * 16; float* ssq_n = ssq_p + (size_t)T_TOK * 16;
        if ((l & 1) == 0) {
            EpiInEven e{QKB, AVT, BVT, ROPEA, ROPEB, P.bq_norm + j * 64, P.bk_norm + j * 64, ssq_a};
            gemm_phase(lds, MIX, DM, wl + WL_WIN, 1024, 2304, e, vbid);
            xcd_barrier(xb);
            const float lam_init = j == 0 ? P.lam_init[0] : P.lam_init[1];
            float lam;
            { const int lane = threadIdx.x & 63; float a = P.lq1[j * 64 + lane] * P.lk1[j * 64 + lane], c = P.lq2[j * 64 + lane] * P.lk2[j * 64 + lane];
#pragma unroll
              for (int o = 32; o >= 1; o >>= 1) { a += __shfl_xor(a, o); c += __shfl_xor(c, o); }
              lam = __expf(a) - __expf(c) + lam_init; }
            for (int u = vbid; u < 1536; u += gridDim.x) {
                if (u < 1024) attn_diff_unit(lds, QKB, AVT, MIX, u, lam, lam_init, P.a_subln + j * 128);
                else attn_gqa2_unit(lds, QKB, BVT, MIX, u - 1024);
            }
            xcd_barrier(xb);
        } else {
            EpiInOdd e{QKB, VT, ssq_a};
            gemm_phase(lds, MIX, DM, wl + WL_WIN, 1024, 3072, e, vbid);
            xcd_barrier(xb);
            for (int u = vbid; u < 2048; u += gridDim.x) attn_na_unit(lds, QKB, VT, MIX, u, P.c_rel_bias + (size_t)j * 16 * 15 * 31);
            xcd_barrier(xb);
        }
        { EpiResid e{xres, X, H, ssq_f}; gemm_phase(lds, MIX, DM, wl + WL_WOUT, 1024, 1024, e, vbid); }
        xcd_barrier(xb);
        { EpiUp e{ACT, HALO, P.conv_w + (size_t)l * 3 * 5632, P.conv_b + (size_t)l * 5632, ssq_f}; gemm_phase(lds, H, DM, wl + WL_WUP, 1024, 5632, e, vbid); }
        { EpiBf16 e{MIX}; gemm_phase(lds, PB, PLE, wl + WL_WPROJ, 256, 1024, e, vbid); }
        xcd_barrier(xb);
        phase_fix(HALO, ACT, P.conv_w + (size_t)l * 3 * 5632, P.conv_b + (size_t)l * 5632);
        if (l < 3) phase_cvt_p(P.p + (size_t)(l + 1) * T_TOK * PLE, PB);
        xcd_barrier(xb);
        { EpiResid e{X, X, H, ssq_p}; gemm_phase(lds, ACT, DFF, wl + WL_WDOWN, 2816, 1024, e, vbid); }
        xcd_barrier(xb);
        { EpiPle e{X, MIX, ssq_p, ssq_n}; gemm_phase(lds, H, DM, wl + WL_WGATE, 1024, 1024, e, vbid); }
        xcd_barrier(xb);
    }
    phase_final_norm(X, P.final_norm);
}

extern "C" void kernel_launch(void* const* d_in, const int* in_sizes, int n_in, void* d_out, int out_size, void* d_ws, size_t ws_size, hipStream_t stream) {
    static int grid_blocks = 0;
    if (!grid_blocks) {
        int dev = 0, cus = 0, per_cu = 0;
        hipGetDevice(&dev);
        hipDeviceGetAttribute(&cus, hipDeviceAttributeMultiprocessorCount, dev);
        if (hipFuncSetAttribute((const void*)fwd_megakernel, hipFuncAttributeMaxDynamicSharedMemorySize, LDS_BYTES) != hipSuccess) fprintf(stderr, "hipFuncSetAttribute failed\n");
        hipOccupancyMaxActiveBlocksPerMultiprocessor(&per_cu, (const void*)fwd_megakernel, NTHREADS, LDS_BYTES);
        if (per_cu < 1) { fprintf(stderr, "occupancy query returned %d\n", per_cu); per_cu = 1; }
        grid_blocks = cus * 1;
    }
    if (ws_size < WS_NEEDED) { fprintf(stderr, "workspace too small: %zu < %zu\n", ws_size, (size_t)WS_NEEDED); return; }
    Params P{};
    const float* const* in = (const float* const*)d_in;
    P.x = in[0]; P.p = in[1]; P.attn_norm = in[2]; P.w_in_ab = in[3]; P.lq1 = in[4]; P.lk1 = in[5]; P.lq2 = in[6]; P.lk2 = in[7];
    P.a_subln = in[8]; P.bq_norm = in[9]; P.bk_norm = in[10]; P.w_out_ab = in[11]; P.w_in_c = in[12]; P.c_rel_bias = in[13]; P.w_out_c = in[14];
    P.ffn_norm = in[15]; P.w_ffn_up = in[16]; P.conv_w = in[17]; P.conv_b = in[18]; P.w_ffn_down = in[19]; P.ple_norm = in[20];
    P.w_ple_gate = in[21]; P.w_ple_proj = in[22]; P.final_norm = in[23];
    P.out = (float*)d_out; P.ws = (char*)d_ws;
    for (int i = 0; i < 8; ++i) P.inv_a[i] = powf(500000.0f, -(float)i / 8.0f);
    for (int i = 0; i < 16; ++i) P.inv_b[i] = powf(10000.0f, -(float)i / 16.0f);
    P.lam_init[0] = (float)(0.8 - 0.6 * exp(-0.3 * 0.0)); P.lam_init[1] = (float)(0.8 - 0.6 * exp(-0.3 * 2.0)); P.lam_init[2] = 0.f; P.lam_init[3] = 0.f;
    hipMemsetAsync((char*)d_ws + OFF_BAR, 0, 16384, stream);
    void* args[] = {&P};
    hipError_t e = hipLaunchCooperativeKernel((const void*)fwd_megakernel, dim3(grid_blocks), dim3(NTHREADS), args, LDS_BYTES, stream);
    if (e != hipSuccess) fprintf(stderr, "cooperative launch failed: %s (grid %d)\n", hipGetErrorString(e), grid_blocks);
}
```

```cpp
#include <hip/hip_runtime.h>
#include <hip/hip_cooperative_groups.h>
#include <cstdio>
#include <cmath>
#include <cstdint>
namespace cg = cooperative_groups;

typedef unsigned short bf16_t;
typedef short bf16x8 __attribute__((ext_vector_type(8)));
typedef float f32x16 __attribute__((ext_vector_type(16)));
typedef float f32x4 __attribute__((ext_vector_type(4)));
typedef float f32x2 __attribute__((ext_vector_type(2)));
typedef unsigned u32x4 __attribute__((ext_vector_type(4)));
typedef unsigned u32x2 __attribute__((ext_vector_type(2)));
typedef __bf16 bf16v2 __attribute__((ext_vector_type(2)));

#define DI __device__ __forceinline__

constexpr int T_TOK = 32768, SEQ = 8192, DM = 1024, DFF = 2816, PLE = 256;
constexpr float EPS = 1e-6f;
constexpr float QSCALE = 0.125f * 1.4426950408889634f;
constexpr float LOG2E = 1.4426950408889634f;
constexpr int NTHREADS = 512;
constexpr int LROW = 144;
constexpr int GT_BYTES = 256 * LROW;
constexpr int LDS_BYTES = 4 * GT_BYTES + 8192 + 512;

constexpr size_t MiB = 1024 * 1024;
constexpr size_t OFF_ROPEA = 0;
constexpr size_t OFF_ROPEB = 524288;
constexpr size_t OFF_BAR = 640 * 1024;
constexpr size_t OFF_WB = 1 * MiB;
constexpr size_t WL_WIN = 0, WL_WOUT = 3145728, WL_WUP = WL_WOUT + 1048576, WL_WDOWN = WL_WUP + 5767168,
                 WL_WGATE = WL_WDOWN + 2883584, WL_WPROJ = WL_WGATE + 1048576, WL_ELEMS = WL_WPROJ + 262144;
constexpr size_t OFF_H = OFF_WB + 108 * MiB;
constexpr size_t OFF_QKB = OFF_H + 64 * MiB;
constexpr size_t OFF_VT = OFF_QKB + 128 * MiB;
constexpr size_t OFF_ACT = OFF_QKB;
constexpr size_t OFF_MIX = OFF_VT + 64 * MiB;
constexpr size_t OFF_HALO = OFF_MIX + 64 * MiB;
constexpr size_t OFF_PB = OFF_HALO + 22 * MiB;
constexpr size_t OFF_SSQ = OFF_PB + 16 * MiB;
constexpr size_t WS_NEEDED = OFF_SSQ + 26 * MiB;
static_assert(WL_ELEMS * 2 * 4 <= 108 * MiB, "weights");
constexpr int QLD = 2048;
constexpr int SREG_BYTES = 18432;

struct Params {
    const float* x; const float* p; const float* attn_norm; const float* w_in_ab;
    const float* lq1; const float* lk1; const float* lq2; const float* lk2;
    const float* a_subln; const float* bq_norm; const float* bk_norm; const float* w_out_ab;
    const float* w_in_c; const float* c_rel_bias; const float* w_out_c; const float* ffn_norm;
    const float* w_ffn_up; const float* conv_w; const float* conv_b; const float* w_ffn_down;
    const float* ple_norm; const float* w_ple_gate; const float* w_ple_proj; const float* final_norm;
    float* out; char* ws;
    float inv_a[8]; float inv_b[16]; float lam_init[4];
};

DI unsigned pk2(float lo, float hi) { f32x2 v = {lo, hi}; return __builtin_bit_cast(unsigned, __builtin_convertvector(v, bf16v2)); }
DI float bf2f(bf16_t b) { return __uint_as_float(((unsigned)b) << 16); }
DI f32x16 mfma32(bf16x8 a, bf16x8 b, f32x16 c) { return __builtin_amdgcn_mfma_f32_32x32x16_bf16(a, b, c, 0, 0, 0); }
DI float fexp2(float x) { return __builtin_amdgcn_exp2f(x); }
DI float frcp(float x) { return __builtin_amdgcn_rcpf(x); }
DI float xhalf_max(float x) { return fmaxf(x, __shfl_xor(x, 32)); }
DI float xhalf_sum(float x) { return x + __shfl_xor(x, 32); }
DI float sigmoidf_(float x) { return frcp(1.0f + fexp2(-x * LOG2E)); }

DI int tidx() { int t = threadIdx.x; asm volatile("" : "+v"(t)); return t; }

template <bool PERM_UP>
DI void convert_weight(char* lds, const float* __restrict__ src, bf16_t* __restrict__ dst, int K, int N, const float* __restrict__ gain = nullptr) {
    float* tile = (float*)lds;
    const int tid = tidx();
    const int ntk = K / 64, ntn = N / 64, nt = ntk * ntn;
    for (int t = blockIdx.x; t < nt; t += gridDim.x) {
        const int k0 = (t / ntn) * 64, n0 = (t % ntn) * 64;
#pragma unroll
        for (int i = 0; i < 8; ++i) { const int idx = tid + NTHREADS * i, k = idx >> 6, n = idx & 63; tile[k * 65 + n] = src[(size_t)(k0 + k) * N + n0 + n] * (gain ? gain[k0 + k] : 1.0f); }
        __syncthreads();
#pragma unroll
        for (int i = 0; i < 4; ++i) {
            const int idx = tid + NTHREADS * i, n = idx >> 5, k2 = idx & 31;
            int nn = n0 + n;
            if (PERM_UP) { const int c = nn < DFF ? nn : nn - DFF; nn = (c >> 5) * 64 + (nn < DFF ? 0 : 32) + (c & 31); }
            *(unsigned*)(dst + (size_t)nn * K + k0 + 2 * k2) = pk2(tile[(2 * k2) * 65 + n], tile[(2 * k2 + 1) * 65 + n]);
        }
        __syncthreads();
    }
}

DI void sincos_acc(float angf, float& sn, float& cs) {
    const double x = (double)angf;
    const double k = __builtin_rint(x * 0.15915494309189535);
    double y = __builtin_fma(-k, 6.283185307179586, x); y = __builtin_fma(-k, 2.4492935982947064e-16, y);
    const double y2 = y * y;
    double ts = y, s = y, tc = 1.0, c = 1.0;
#pragma unroll 1
    for (int n = 1; n <= 14; ++n) {
        tc *= -y2 / (double)((2 * n - 1) * (2 * n)); c += tc;
        ts *= -y2 / (double)((2 * n) * (2 * n + 1)); s += ts;
    }
    sn = (float)s; cs = (float)c;
}

DI void phase_prep(const Params& P, char* lds) {
    bf16_t* wb = (bf16_t*)(P.ws + OFF_WB);
    for (int l = 0; l < 4; ++l) {
        bf16_t* wl = wb + (size_t)l * WL_ELEMS; const int j = l >> 1;
        if ((l & 1) == 0) { convert_weight<false>(lds, P.w_in_ab + (size_t)j * 1024 * 2304, wl + WL_WIN, 1024, 2304, P.attn_norm + l * DM); convert_weight<false>(lds, P.w_out_ab + (size_t)j * 1024 * 1024, wl + WL_WOUT, 1024, 1024); }
        else { convert_weight<false>(lds, P.w_in_c + (size_t)j * 1024 * 3072, wl + WL_WIN, 1024, 3072, P.attn_norm + l * DM); convert_weight<false>(lds, P.w_out_c + (size_t)j * 1024 * 1024, wl + WL_WOUT, 1024, 1024); }
        convert_weight<true>(lds, P.w_ffn_up + (size_t)l * 1024 * 5632, wl + WL_WUP, 1024, 5632, P.ffn_norm + l * DM);
        convert_weight<false>(lds, P.w_ffn_down + (size_t)l * 2816 * 1024, wl + WL_WDOWN, 2816, 1024);
        convert_weight<false>(lds, P.w_ple_gate + (size_t)l * 1024 * 1024, wl + WL_WGATE, 1024, 1024, P.ple_norm + l * DM);
        convert_weight<false>(lds, P.w_ple_proj + (size_t)l * 256 * 1024, wl + WL_WPROJ, 256, 1024);
    }
    f32x2* ra = (f32x2*)(P.ws + OFF_ROPEA); f32x2* rb = (f32x2*)(P.ws + OFF_ROPEB);
    for (int i = blockIdx.x * NTHREADS + tidx(); i < 8192 + 128; i += gridDim.x * NTHREADS) {
        float sn, cs;
        if (i < 8192) {
#pragma unroll
            for (int k = 0; k < 8; ++k) { const float ang = (float)i * P.inv_a[k]; sincos_acc(ang, sn, cs); ra[i * 8 + k] = (f32x2){cs, sn}; }
        } else {
            const int q = i - 8192;
#pragma unroll
            for (int k = 0; k < 16; ++k) { const float ang = (float)q * P.inv_b[k]; sincos_acc(ang, sn, cs); rb[q * 16 + k] = (f32x2){cs, sn}; }
        }
    }
}

DI void phase_x0(const float* __restrict__ src, bf16_t* __restrict__ dst, float* __restrict__ ssq) {
    const int lane = tidx() & 63, wv = blockIdx.x * 8 + (tidx() >> 6), nw = gridDim.x * 8;
    for (int row = wv; row < T_TOK; row += nw) {
        const float* sp = src + (size_t)row * DM; f32x4 v[4]; float ss = 0.f;
#pragma unroll
        for (int i = 0; i < 4; ++i) { v[i] = *(const f32x4*)(sp + (i * 64 + lane) * 4); ss += v[i][0] * v[i][0] + v[i][1] * v[i][1] + v[i][2] * v[i][2] + v[i][3] * v[i][3]; }
#pragma unroll
        for (int o = 32; o >= 1; o >>= 1) ss += __shfl_xor(ss, o);
#pragma unroll
        for (int i = 0; i < 4; ++i) { u32x2 w; w.x = pk2(v[i][0], v[i][1]); w.y = pk2(v[i][2], v[i][3]); *(u32x2*)(dst + (size_t)row * DM + (i * 64 + lane) * 4) = w; }
        if (lane < 16) ssq[(size_t)lane * T_TOK + row] = lane == 0 ? ss : 0.f;
    }
}
DI float rstd_of(float ssq) { return __builtin_amdgcn_rsqf(ssq * (1.0f / DM) + EPS); }
DI float* wave_rstd_table(const float* __restrict__ ssqp, int tok0w, const char* xtra, int lane) {
    float* tbl = (float*)(xtra + 4096) + (tidx() >> 6) * 128;
    {
        const float* p = ssqp + tok0w + 2 * lane;
        f32x2 a[16];
#pragma unroll
        for (int i = 0; i < 16; ++i) a[i] = *(const f32x2*)(p + (size_t)i * T_TOK);
        const f32x2 t = (((a[0] + a[1]) + (a[2] + a[3])) + ((a[4] + a[5]) + (a[6] + a[7]))) + (((a[8] + a[9]) + (a[10] + a[11])) + ((a[12] + a[13]) + (a[14] + a[15])));
        *(f32x2*)(tbl + 2 * lane) = (f32x2){rstd_of(t.x), rstd_of(t.y)};
    }
    return tbl;
}

DI void phase_norm(const float* __restrict__ src, const float* __restrict__ g, bf16_t* __restrict__ dst) {
    const int lane = tidx() & 63, wv = blockIdx.x * 8 + (tidx() >> 6), nw = gridDim.x * 8;
    f32x4 gv[4];
#pragma unroll
    for (int i = 0; i < 4; ++i) gv[i] = *(const f32x4*)(g + (i * 64 + lane) * 4);
    for (int row = wv; row < T_TOK; row += nw) {
        const float* s = src + (size_t)row * DM; f32x4 v[4]; float ss = 0.f;
#pragma unroll
        for (int i = 0; i < 4; ++i) { v[i] = *(const f32x4*)(s + (i * 64 + lane) * 4); ss += v[i][0] * v[i][0] + v[i][1] * v[i][1] + v[i][2] * v[i][2] + v[i][3] * v[i][3]; }
#pragma unroll
        for (int o = 32; o >= 1; o >>= 1) ss += __shfl_xor(ss, o);
        const float rs = __builtin_amdgcn_rsqf(ss * (1.0f / DM) + EPS);
#pragma unroll
        for (int i = 0; i < 4; ++i) { u32x2 w; w.x = pk2(v[i][0] * rs * gv[i][0], v[i][1] * rs * gv[i][1]); w.y = pk2(v[i][2] * rs * gv[i][2], v[i][3] * rs * gv[i][3]); *(u32x2*)(dst + (size_t)row * DM + (i * 64 + lane) * 4) = w; }
    }
}
DI void phase_final_norm(float* __restrict__ x, const float* __restrict__ g) {
    const int lane = tidx() & 63, wv = blockIdx.x * 8 + (tidx() >> 6), nw = gridDim.x * 8;
    f32x4 gv[4];
#pragma unroll
    for (int i = 0; i < 4; ++i) gv[i] = *(const f32x4*)(g + (i * 64 + lane) * 4);
    for (int row = wv; row < T_TOK; row += nw) {
        float* s = x + (size_t)row * DM; f32x4 v[4]; float ss = 0.f;
#pragma unroll
        for (int i = 0; i < 4; ++i) { v[i] = *(const f32x4*)(s + (i * 64 + lane) * 4); ss += v[i][0] * v[i][0] + v[i][1] * v[i][1] + v[i][2] * v[i][2] + v[i][3] * v[i][3]; }
#pragma unroll
        for (int o = 32; o >= 1; o >>= 1) ss += __shfl_xor(ss, o);
        const float rs = __builtin_amdgcn_rsqf(ss * (1.0f / DM) + EPS);
#pragma unroll
        for (int i = 0; i < 4; ++i) *(f32x4*)(s + (i * 64 + lane) * 4) = v[i] * rs * gv[i];
    }
}
DI void phase_cvt_p(const float* __restrict__ src, bf16_t* __restrict__ dst) {
    const size_t n4 = (size_t)T_TOK * PLE / 4;
    for (size_t i = (size_t)blockIdx.x * NTHREADS + tidx(); i < n4; i += (size_t)gridDim.x * NTHREADS) {
        const f32x4 v = *(const f32x4*)(src + i * 4); u32x2 w; w.x = pk2(v[0], v[1]); w.y = pk2(v[2], v[3]); *(u32x2*)(dst + i * 4) = w;
    }
}

template <class Epi, bool SWP>
DI void gemm_tile(char* lds, const bf16_t* __restrict__ A, int lda, const bf16_t* __restrict__ Bt, int K, int tok0, int col0, const Epi& epi) {
    const int tid = tidx(), lane = tid & 63, wid = __builtin_amdgcn_readfirstlane(tid >> 6), wm = wid & 1, wn = wid >> 1, r = lane & 31, h = lane >> 5;
    const int lrow = tid >> 3, lkc = tid & 7;
    const bf16_t* ga = A + (size_t)(tok0 + lrow) * lda + lkc * 8;
    const bf16_t* gb = Bt + (size_t)(col0 + lrow) * K + lkc * 8;
    const int lw = lrow * LROW + lkc * 16;
    int lwa[4];
#pragma unroll
    for (int i = 0; i < 4; ++i) {
        if (Epi::PERM_TOK) { const int gr = lrow + 64 * i, tau = gr & 127; lwa[i] = ((gr & 128) + (tau & 3) * 32 + (tau >> 2)) * LROW + lkc * 16; }
        else lwa[i] = lw + 64 * i * LROW;
    }
    u32x4 ra[4], rb[4];
#pragma unroll
    for (int i = 0; i < 4; ++i) { ra[i] = *(const u32x4*)(ga + (size_t)(64 * i) * lda); rb[i] = *(const u32x4*)(gb + (size_t)(64 * i) * K); }
    epi.tile_prologue(lds, col0, tid);
    f32x16 acc[2][4];
#pragma unroll
    for (int a = 0; a < 2; ++a)
#pragma unroll
        for (int b = 0; b < 4; ++b)
#pragma unroll
            for (int i = 0; i < 16; ++i) acc[a][b][i] = 0.f;
#pragma unroll
    for (int i = 0; i < 4; ++i) { *(u32x4*)(lds + lwa[i]) = ra[i]; *(u32x4*)(lds + GT_BYTES + lw + 64 * i * LROW) = rb[i]; }
    __syncthreads();
    const int nk = K / 64;
    if (nk > 1) {
#pragma unroll
        for (int i = 0; i < 4; ++i) { ra[i] = *(const u32x4*)(ga + (size_t)(64 * i) * lda + 64); rb[i] = *(const u32x4*)(gb + (size_t)(64 * i) * K + 64); }
    }
#pragma unroll 1
    for (int kt = 0; kt < nk; ++kt) {
        const bool more = kt + 1 < nk, more2 = kt + 2 < nk;
        const char* sa = lds + (kt & 1) * 2 * GT_BYTES + (wm * 128 + r) * LROW + h * 16;
        const char* sb = lds + (kt & 1) * 2 * GT_BYTES + GT_BYTES + (wn * 64 + r) * LROW + h * 16;
        bf16x8 wf[2][2], xf[2][4];
#pragma unroll
        for (int fb = 0; fb < 2; ++fb) wf[0][fb] = *(const bf16x8*)(sb + fb * 32 * LROW);
#pragma unroll
        for (int tb = 0; tb < 4; ++tb) xf[0][tb] = *(const bf16x8*)(sa + tb * 32 * LROW);
#pragma unroll
        for (int t = 0; t < 4; ++t) {
            if (t < 3) {
#pragma unroll
                for (int fb = 0; fb < 2; ++fb) wf[(t + 1) & 1][fb] = *(const bf16x8*)(sb + fb * 32 * LROW + (t + 1) * 32);
#pragma unroll
                for (int tb = 0; tb < 4; ++tb) xf[(t + 1) & 1][tb] = *(const bf16x8*)(sa + tb * 32 * LROW + (t + 1) * 32);
            }
            if (t == 3 && more) {
                char* d = lds + ((kt + 1) & 1) * 2 * GT_BYTES;
#pragma unroll
                for (int i = 0; i < 4; ++i) { *(u32x4*)(d + lwa[i]) = ra[i]; *(u32x4*)(d + GT_BYTES + lw + 64 * i * LROW) = rb[i]; }
                if (more2) {
#pragma unroll
                    for (int i = 0; i < 4; ++i) { ra[i] = *(const u32x4*)(ga + (size_t)(64 * i) * lda + (kt + 2) * 64); rb[i] = *(const u32x4*)(gb + (size_t)(64 * i) * K + (kt + 2) * 64); }
                }
                __builtin_amdgcn_sched_barrier(0);
            }
#pragma unroll
            for (int fb = 0; fb < 2; ++fb)
#pragma unroll
                for (int tb = 0; tb < 4; ++tb) acc[fb][tb] = SWP ? mfma32(wf[t & 1][fb], xf[t & 1][tb], acc[fb][tb]) : mfma32(xf[t & 1][tb], wf[t & 1][fb], acc[fb][tb]);
            __builtin_amdgcn_sched_barrier(0);
        }
        __syncthreads();
    }
    char* sreg = lds + wid * SREG_BYTES;
    if (SWP) epi.swp(acc, tok0 + wm * 128, col0 + wn * 64, r, h, sreg, lds + 4 * GT_BYTES); else epi.nsw(acc, tok0 + wm * 128, col0 + wn * 64, r, h, sreg, lds + 4 * GT_BYTES);
    if (Epi::STAGED) __syncthreads();
}

template <class Epi>
DI void gemm_phase(char* lds, const bf16_t* A, int lda, const bf16_t* Bt, int K, int N, const Epi& epi, int vbid) {
    const int nN = N / 256;
    const int wn = __builtin_amdgcn_readfirstlane(tidx() >> 7);
    const int G = gridDim.x, bid = vbid;
    if ((G & 7) == 0) {
        const int x = bid & 7, per = G >> 3, nq = 16 * nN;
        for (int q = bid >> 3; q < nq; q += per) {
            const int tok0 = (16 * x + (q & 7) + 8 * (q / (8 * nN))) * 256, col0 = ((q >> 3) % nN) * 256;
            if (!Epi::HAS_NSW || epi.swapped(col0 + wn * 64)) gemm_tile<Epi, true>(lds, A, lda, Bt, K, tok0, col0, epi);
            else gemm_tile<Epi, false>(lds, A, lda, Bt, K, tok0, col0, epi);
        }
    } else {
        const int nU = (T_TOK / 256) * nN;
        for (int u = bid; u < nU; u += G) {
            const int tok0 = (u / nN) * 256, col0 = (u % nN) * 256;
            if (!Epi::HAS_NSW || epi.swapped(col0 + wn * 64)) gemm_tile<Epi, true>(lds, A, lda, Bt, K, tok0, col0, epi);
            else gemm_tile<Epi, false>(lds, A, lda, Bt, K, tok0, col0, epi);
        }
    }
}

DI void st_bf4(bf16_t* p, float a, float b, float c, float d) { u32x2 w; w.x = pk2(a, b); w.y = pk2(c, d); *(u32x2*)p = w; }
DI void lds_put4(char* p, float a, float b, float c, float d) { u32x2 w; w.x = pk2(a, b); w.y = pk2(c, d); *(u32x2*)p = w; }
template <int NROWS, int ROWB, bool SKIP_EDGES>
DI void stage_flush(const char* sreg, int lane, bf16_t* gbase, size_t gstride) {
    constexpr int CPR = ROWB / 16, TOTAL = NROWS * CPR;
    static_assert(NROWS * (ROWB + 16) <= SREG_BYTES, "staging region");
#pragma unroll
    for (int i = 0; i < TOTAL / 64; ++i) {
        const int idx = lane + 64 * i, row = idx / CPR, ch = idx % CPR;
        const u32x4 v = *(const u32x4*)(sreg + row * (ROWB + 16) + ch * 16);
        if (!SKIP_EDGES || (row != 0 && row != NROWS - 1)) *(u32x4*)(gbase + (size_t)row * gstride + ch * 8) = v;
    }
}

struct EpiInEven {
    bf16_t* qkb; bf16_t* avt; bf16_t* bvt; const f32x2* ropea; const f32x2* ropeb; const float* qn; const float* kn; const float* ssq;
    static constexpr bool HAS_NSW = true, PERM_TOK = false, STAGED = true;
    DI void tile_prologue(char*, int, int) const {}
    DI bool swapped(int f0) const { return !((f0 >= 1024 && f0 < 1536) || f0 >= 2176); }
    DI void nsw(f32x16 (&acc)[2][4], int tok0w, int f0w, int r, int h, char* sreg, const char* xtra) const {
        {
            const float* tbl = wave_rstd_table(ssq, tok0w, xtra, 32 * h + r);
#pragma unroll
            for (int tb = 0; tb < 4; ++tb)
#pragma unroll
                for (int g = 0; g < 4; ++g) { const f32x4 q = *(const f32x4*)(tbl + 32 * tb + 8 * g + 4 * h);
#pragma unroll
                    for (int e = 0; e < 4; ++e) { acc[0][tb][4 * g + e] *= q[e]; acc[1][tb][4 * g + e] *= q[e]; } }
        }
        {
            bf16_t* base; int drow0;
            if (f0w < 1536) { const int c = f0w - 1024; base = avt; drow0 = ((tok0w >> 13) * 4 + (c >> 7)) * 128 + (c & 127); }
            else { const int c = f0w - 2176; base = bvt; drow0 = ((tok0w >> 13) * 2 + (c >> 6)) * 64; }
            const int s0 = tok0w & (SEQ - 1);
#pragma unroll
            for (int fb = 0; fb < 2; ++fb)
#pragma unroll
                for (int tb = 0; tb < 4; ++tb)
#pragma unroll
                    for (int g = 0; g < 4; ++g)
                        lds_put4(sreg + (32 * fb + r) * 272 + (32 * tb + 8 * g + 4 * h) * 2, acc[fb][tb][4 * g], acc[fb][tb][4 * g + 1], acc[fb][tb][4 * g + 2], acc[fb][tb][4 * g + 3]);
            stage_flush<64, 256, false>(sreg, 32 * h + r, base + (size_t)drow0 * SEQ + s0, SEQ);
        }
    }
    DI void swp(f32x16 (&acc)[2][4], int tok0w, int f0w, int r, int h, char* sreg, const char* xtra) const {
        {
            const float* tbl = wave_rstd_table(ssq, tok0w, xtra, 32 * h + r);
#pragma unroll
            for (int tb = 0; tb < 4; ++tb) { const float rs = tbl[32 * tb + r];
#pragma unroll
                for (int fb = 0; fb < 2; ++fb)
#pragma unroll
                    for (int i = 0; i < 16; ++i) acc[fb][tb][i] *= rs; }
        }
        if (f0w < 1024) {
            const float sc = f0w < 512 ? QSCALE : 1.0f;
#pragma unroll
            for (int tb = 0; tb < 4; ++tb) {
                const int t = tok0w + 32 * tb + r, s = t & (SEQ - 1);
                const f32x4 cs0 = *(const f32x4*)(ropea + s * 8 + 4 * h), cs1 = *(const f32x4*)(ropea + s * 8 + 4 * h + 2);
                const float c[4] = {cs0[0], cs0[2], cs1[0], cs1[2]}, sn[4] = {cs0[1], cs0[3], cs1[1], cs1[3]};
#pragma unroll
                for (int e = 0; e < 4; ++e) { const float x1 = acc[0][tb][e], x2 = acc[0][tb][4 + e]; acc[0][tb][e] = x1 * c[e] - x2 * sn[e]; acc[0][tb][4 + e] = x2 * c[e] + x1 * sn[e]; }
#pragma unroll
                for (int fb = 0; fb < 2; ++fb)
#pragma unroll
                    for (int g = 0; g < 4; ++g)
                        lds_put4(sreg + (32 * tb + r) * 144 + (32 * fb + 8 * g + 4 * h) * 2, acc[fb][tb][4 * g] * sc, acc[fb][tb][4 * g + 1] * sc, acc[fb][tb][4 * g + 2] * sc, acc[fb][tb][4 * g + 3] * sc);
            }
            stage_flush<128, 128, false>(sreg, 32 * h + r, qkb + (size_t)tok0w * QLD + f0w, QLD);
            return;
        }
        const bool isq = f0w < 2048; const float sc = isq ? QSCALE : 1.0f; const float* gn = isq ? qn : kn;
        const int ocol = isq ? (1024 + f0w - 1536) : (1536 + f0w - 2048);
        f32x4 gv[2][4];
#pragma unroll
        for (int fb = 0; fb < 2; ++fb)
#pragma unroll
            for (int g = 0; g < 4; ++g) gv[fb][g] = *(const f32x4*)(gn + 32 * fb + 8 * g + 4 * h);
#pragma unroll
        for (int tb = 0; tb < 4; ++tb) {
            const int t = tok0w + 32 * tb + r, s = t & (SEQ - 1);
            float ss = 0.f;
#pragma unroll
            for (int fb = 0; fb < 2; ++fb)
#pragma unroll
                for (int i = 0; i < 16; ++i) ss += acc[fb][tb][i] * acc[fb][tb][i];
            ss += __shfl_xor(ss, 32);
            const float rs = __builtin_amdgcn_rsqf(ss * (1.0f / 64.0f) + EPS);
#pragma unroll
            for (int fb = 0; fb < 2; ++fb)
#pragma unroll
                for (int g = 0; g < 4; ++g)
#pragma unroll
                    for (int e = 0; e < 4; ++e) acc[fb][tb][4 * g + e] *= rs * gv[fb][g][e];
#pragma unroll
            for (int fb = 0; fb < 2; ++fb) {
                const int pos = fb == 0 ? (s >> 6) : (s & 63);
#pragma unroll
                for (int g = 0; g < 2; ++g) {
                    const f32x4 cs0 = *(const f32x4*)(ropeb + pos * 16 + 8 * g + 4 * h), cs1 = *(const f32x4*)(ropeb + pos * 16 + 8 * g + 4 * h + 2);
                    const float c[4] = {cs0[0], cs0[2], cs1[0], cs1[2]}, sn[4] = {cs0[1], cs0[3], cs1[1], cs1[3]};
#pragma unroll
                    for (int e = 0; e < 4; ++e) { const float x1 = acc[fb][tb][4 * g + e], x2 = acc[fb][tb][4 * (g + 2) + e]; acc[fb][tb][4 * g + e] = x1 * c[e] - x2 * sn[e]; acc[fb][tb][4 * (g + 2) + e] = x2 * c[e] + x1 * sn[e]; }
                }
            }
#pragma unroll
            for (int fb = 0; fb < 2; ++fb)
#pragma unroll
                for (int g = 0; g < 4; ++g)
                    lds_put4(sreg + (32 * tb + r) * 144 + (32 * fb + 8 * g + 4 * h) * 2, acc[fb][tb][4 * g] * sc, acc[fb][tb][4 * g + 1] * sc, acc[fb][tb][4 * g + 2] * sc, acc[fb][tb][4 * g + 3] * sc);
        }
        stage_flush<128, 128, false>(sreg, 32 * h + r, qkb + (size_t)tok0w * QLD + ocol, QLD);
    }
};

struct EpiInOdd {
    bf16_t* qkb; bf16_t* cvt; const float* ssq;
    static constexpr bool HAS_NSW = true, PERM_TOK = false, STAGED = true;
    DI void tile_prologue(char*, int, int) const {}
    DI bool swapped(int f0) const { return f0 < 2048; }
    DI void nsw(f32x16 (&acc)[2][4], int tok0w, int f0w, int r, int h, char* sreg, const char* xtra) const {
        {
            const float* tbl = wave_rstd_table(ssq, tok0w, xtra, 32 * h + r);
#pragma unroll
            for (int tb = 0; tb < 4; ++tb)
#pragma unroll
                for (int g = 0; g < 4; ++g) { const f32x4 q = *(const f32x4*)(tbl + 32 * tb + 8 * g + 4 * h);
#pragma unroll
                    for (int e = 0; e < 4; ++e) { acc[0][tb][4 * g + e] *= q[e]; acc[1][tb][4 * g + e] *= q[e]; } }
        }
        {
            const int c = f0w - 2048; const int drow0 = ((tok0w >> 13) * 16 + (c >> 6)) * 64; const int s0 = tok0w & (SEQ - 1);
#pragma unroll
            for (int fb = 0; fb < 2; ++fb)
#pragma unroll
                for (int tb = 0; tb < 4; ++tb)
#pragma unroll
                    for (int g = 0; g < 4; ++g)
                        lds_put4(sreg + (32 * fb + r) * 272 + (32 * tb + 8 * g + 4 * h) * 2, acc[fb][tb][4 * g], acc[fb][tb][4 * g + 1], acc[fb][tb][4 * g + 2], acc[fb][tb][4 * g + 3]);
            stage_flush<64, 256, false>(sreg, 32 * h + r, cvt + (size_t)drow0 * SEQ + s0, SEQ);
        }
    }
    DI void swp(f32x16 (&acc)[2][4], int tok0w, int f0w, int r, int h, char* sreg, const char* xtra) const {
        {
            const float* tbl = wave_rstd_table(ssq, tok0w, xtra, 32 * h + r);
#pragma unroll
            for (int tb = 0; tb < 4; ++tb) { const float rs = tbl[32 * tb + r];
#pragma unroll
                for (int fb = 0; fb < 2; ++fb)
#pragma unroll
                    for (int i = 0; i < 16; ++i) acc[fb][tb][i] *= rs; }
        }
        const float sc = f0w < 1024 ? QSCALE : 1.0f;
#pragma unroll
        for (int tb = 0; tb < 4; ++tb) {
            const int t = tok0w + 32 * tb + r;
#pragma unroll
            for (int fb = 0; fb < 2; ++fb)
#pragma unroll
                for (int g = 0; g < 4; ++g)
                    lds_put4(sreg + (32 * tb + r) * 144 + (32 * fb + 8 * g + 4 * h) * 2, acc[fb][tb][4 * g] * sc, acc[fb][tb][4 * g + 1] * sc, acc[fb][tb][4 * g + 2] * sc, acc[fb][tb][4 * g + 3] * sc);
        }
        stage_flush<128, 128, false>(sreg, 32 * h + r, qkb + (size_t)tok0w * QLD + f0w, QLD);
    }
};

struct EpiResid {
    const float* res; float* out; bf16_t* xb; float* ssq;
    static constexpr bool HAS_NSW = false, PERM_TOK = false, STAGED = true;
    DI void tile_prologue(char*, int, int) const {}
    DI bool swapped(int) const { return true; }
    DI void nsw(f32x16 (&)[2][4], int, int, int, int, char*, const char*) const {}
    DI void swp(f32x16 (&acc)[2][4], int tok0w, int f0w, int r, int h, char* sreg, const char* xtra) const {
        f32x4 rv[2][8];
        const size_t base = (size_t)(tok0w + r) * DM + f0w + 4 * h;
#pragma unroll
        for (int q = 0; q < 8; ++q) rv[0][q] = *(const f32x4*)(res + base + 32 * (q >> 2) + 8 * (q & 3));
#pragma unroll
        for (int tb = 0; tb < 4; ++tb) {
            if (tb < 3) {
#pragma unroll
                for (int q = 0; q < 8; ++q) rv[(tb + 1) & 1][q] = *(const f32x4*)(res + base + (size_t)(32 * (tb + 1)) * DM + 32 * (q >> 2) + 8 * (q & 3));
            }
            float ss = 0.f;
#pragma unroll
            for (int q = 0; q < 8; ++q) {
                const int fb = q >> 2, g = q & 3; const f32x4 c = rv[tb & 1][q];
                f32x4 v = {acc[fb][tb][4 * g] + c[0], acc[fb][tb][4 * g + 1] + c[1], acc[fb][tb][4 * g + 2] + c[2], acc[fb][tb][4 * g + 3] + c[3]};
                *(f32x4*)(out + base + (size_t)(32 * tb) * DM + 32 * fb + 8 * g) = v;
                ss += v[0] * v[0] + v[1] * v[1] + v[2] * v[2] + v[3] * v[3];
                lds_put4(sreg + (32 * tb + r) * 144 + (32 * fb + 8 * g + 4 * h) * 2, v[0], v[1], v[2], v[3]);
            }
            ss = xhalf_sum(ss);
            if (h == 0) ssq[(size_t)(f0w >> 6) * T_TOK + tok0w + 32 * tb + r] = ss;
        }
        stage_flush<128, 128, false>(sreg, 32 * h + r, xb + (size_t)tok0w * DM + f0w, DM);
    }
};

struct EpiBf16 {
    bf16_t* out;
    static constexpr bool HAS_NSW = false, PERM_TOK = false, STAGED = true;
    DI void tile_prologue(char*, int, int) const {}
    DI bool swapped(int) const { return true; }
    DI void nsw(f32x16 (&)[2][4], int, int, int, int, char*, const char*) const {}
    DI void swp(f32x16 (&acc)[2][4], int tok0w, int f0w, int r, int h, char* sreg, const char* xtra) const {
#pragma unroll
        for (int tb = 0; tb < 4; ++tb)
#pragma unroll
            for (int fb = 0; fb < 2; ++fb)
#pragma unroll
                for (int g = 0; g < 4; ++g)
                    lds_put4(sreg + (32 * tb + r) * 144 + (32 * fb + 8 * g + 4 * h) * 2, acc[fb][tb][4 * g], acc[fb][tb][4 * g + 1], acc[fb][tb][4 * g + 2], acc[fb][tb][4 * g + 3]);
        stage_flush<128, 128, false>(sreg, 32 * h + r, out + (size_t)tok0w * DM + f0w, DM);
    }
};

struct EpiPle {
    float* x; bf16_t* pj; const float* ssq_in; float* ssq_out;
    static constexpr bool HAS_NSW = false, PERM_TOK = false, STAGED = true;
    DI void tile_prologue(char*, int, int) const {}
    DI bool swapped(int) const { return true; }
    DI void nsw(f32x16 (&)[2][4], int, int, int, int, char*, const char*) const {}
    DI void swp(f32x16 (&acc)[2][4], int tok0w, int f0w, int r, int h, char* sreg, const char* xtra) const {
        f32x4 rv[2][8]; u32x2 pw[2][8];
        const float* tbl = wave_rstd_table(ssq_in, tok0w, xtra, 32 * h + r);
        const size_t base = (size_t)(tok0w + r) * DM + f0w + 4 * h;
#pragma unroll
        for (int q = 0; q < 8; ++q) { const size_t o = base + 32 * (q >> 2) + 8 * (q & 3); rv[0][q] = *(const f32x4*)(x + o); pw[0][q] = *(const u32x2*)(pj + o); }
#pragma unroll
        for (int tb = 0; tb < 4; ++tb) {
            if (tb < 3) {
#pragma unroll
                for (int q = 0; q < 8; ++q) { const size_t o = base + (size_t)(32 * (tb + 1)) * DM + 32 * (q >> 2) + 8 * (q & 3); rv[(tb + 1) & 1][q] = *(const f32x4*)(x + o); pw[(tb + 1) & 1][q] = *(const u32x2*)(pj + o); }
            }
            const float rs = tbl[32 * tb + r];
            float ss = 0.f;
#pragma unroll
            for (int q = 0; q < 8; ++q) {
                const int fb = q >> 2, g = q & 3; const f32x4 c = rv[tb & 1][q]; const u32x2 w = pw[tb & 1][q];
                const float p0 = __uint_as_float(w.x << 16), p1 = __uint_as_float(w.x & 0xffff0000u), p2 = __uint_as_float(w.y << 16), p3 = __uint_as_float(w.y & 0xffff0000u);
                f32x4 v = {c[0] + sigmoidf_(acc[fb][tb][4 * g] * rs) * p0, c[1] + sigmoidf_(acc[fb][tb][4 * g + 1] * rs) * p1, c[2] + sigmoidf_(acc[fb][tb][4 * g + 2] * rs) * p2, c[3] + sigmoidf_(acc[fb][tb][4 * g + 3] * rs) * p3};
                *(f32x4*)(x + base + (size_t)(32 * tb) * DM + 32 * fb + 8 * g) = v;
                ss += v[0] * v[0] + v[1] * v[1] + v[2] * v[2] + v[3] * v[3];
                lds_put4(sreg + (32 * tb + r) * 144 + (32 * fb + 8 * g + 4 * h) * 2, v[0], v[1], v[2], v[3]);
            }
            ss = xhalf_sum(ss);
            if (h == 0) ssq_out[(size_t)(f0w >> 6) * T_TOK + tok0w + 32 * tb + r] = ss;
        }
        stage_flush<128, 128, false>(sreg, 32 * h + r, pj + (size_t)tok0w * DM + f0w, DM);
    }
};

DI float dpp_prev(float v) { return __builtin_bit_cast(float, __builtin_amdgcn_update_dpp(0, __builtin_bit_cast(int, v), 0x138, 0xf, 0xf, false)); }
DI float dpp_next(float v) { return __builtin_bit_cast(float, __builtin_amdgcn_update_dpp(0, __builtin_bit_cast(int, v), 0x130, 0xf, 0xf, false)); }
struct EpiUp {
    bf16_t* act; float* halo; const float* cw; const float* cb; const float* ssq;
    static constexpr bool HAS_NSW = false, PERM_TOK = true, STAGED = true;
    DI bool swapped(int) const { return true; }
    DI void tile_prologue(char* lds, int col0, int tid) const {
        float* pl = (float*)(lds + 4 * GT_BYTES);
        const int idx = tid * 2, p = idx >> 8, slot = idx & 255, pc = col0 + slot;
        const int ch = (pc >> 6) * 32 + (slot & 31) + ((slot >> 5) & 1) * DFF;
        const f32x2 v = p < 3 ? *(const f32x2*)(cw + p * 5632 + ch) : *(const f32x2*)(cb + ch);
        *(f32x2*)(pl + idx) = v;
    }
    DI void nsw(f32x16 (&)[2][4], int, int, int, int, char*, const char*) const {}
    DI void swp(f32x16 (&acc)[2][4], int tok0w, int f0w, int r, int h, char* sreg, const char* xtra) const {
        {
            const float* tbl = wave_rstd_table(ssq, tok0w, xtra, 32 * h + r);
            const f32x4 q = *(const f32x4*)(tbl + 4 * r);
#pragma unroll
            for (int tb = 0; tb < 4; ++tb) { const float rs = q[tb];
#pragma unroll
                for (int fb = 0; fb < 2; ++fb)
#pragma unroll
                    for (int i = 0; i < 16; ++i) acc[fb][tb][i] *= rs; }
        }
        const int c0 = (f0w >> 6) * 32;
        float* hl = halo + (size_t)(tok0w >> 7) * 4 * 5632;
        const float* pl = (const float*)xtra + (f0w & 255);
#pragma unroll
        for (int g = 0; g < 4; ++g) {
            const int c = c0 + 8 * g + 4 * h;
            f32x4 w0[2], w1[2], w2[2], bb[2];
#pragma unroll
            for (int fb = 0; fb < 2; ++fb) { const int sl = 32 * fb + 8 * g + 4 * h; w0[fb] = *(const f32x4*)(pl + sl); w1[fb] = *(const f32x4*)(pl + 256 + sl); w2[fb] = *(const f32x4*)(pl + 512 + sl); bb[fb] = *(const f32x4*)(pl + 768 + sl); }
            float o[4][4];
#pragma unroll
            for (int e = 0; e < 4; ++e) {
                float cv[2][4];
#pragma unroll
                for (int fb = 0; fb < 2; ++fb) {
                    const float u0 = acc[fb][0][4 * g + e], u1 = acc[fb][1][4 * g + e], u2 = acc[fb][2][4 * g + e], u3 = acc[fb][3][4 * g + e];
                    const float pv = dpp_prev(u3), nx = dpp_next(u0);
                    const float a0 = w0[fb][e], a1 = w1[fb][e], a2 = w2[fb][e], b0 = bb[fb][e];
                    cv[fb][0] = pv * a0 + (u0 * a1 + (u1 * a2 + b0));
                    cv[fb][1] = u0 * a0 + (u1 * a1 + (u2 * a2 + b0));
                    cv[fb][2] = u1 * a0 + (u2 * a1 + (u3 * a2 + b0));
                    cv[fb][3] = u2 * a0 + (u3 * a1 + (nx * a2 + b0));
                }
#pragma unroll
                for (int tb = 0; tb < 4; ++tb) o[tb][e] = cv[0][tb] * sigmoidf_(cv[0][tb]) * cv[1][tb];
            }
#pragma unroll
            for (int tb = 0; tb < 4; ++tb) lds_put4(sreg + (4 * r + tb) * 80 + (8 * g + 4 * h) * 2, o[tb][0], o[tb][1], o[tb][2], o[tb][3]);
            if (r == 0) {
#pragma unroll
                for (int fb = 0; fb < 2; ++fb)
#pragma unroll
                    for (int tb = 0; tb < 2; ++tb) *(f32x4*)(hl + (size_t)tb * 5632 + c + fb * DFF) = (f32x4){acc[fb][tb][4 * g], acc[fb][tb][4 * g + 1], acc[fb][tb][4 * g + 2], acc[fb][tb][4 * g + 3]};
            }
            if (r == 31) {
#pragma unroll
                for (int fb = 0; fb < 2; ++fb)
#pragma unroll
                    for (int tb = 2; tb < 4; ++tb) *(f32x4*)(hl + (size_t)tb * 5632 + c + fb * DFF) = (f32x4){acc[fb][tb][4 * g], acc[fb][tb][4 * g + 1], acc[fb][tb][4 * g + 2], acc[fb][tb][4 * g + 3]};
            }
        }
        stage_flush<128, 64, true>(sreg, 32 * h + r, act + (size_t)tok0w * DFF + c0, DFF);
    }
};

DI void phase_fix(const float* __restrict__ halo, bf16_t* __restrict__ act, const float* __restrict__ cw, const float* __restrict__ cb) {
    const int total = 256 * 2 * DFF;
    for (int i = blockIdx.x * NTHREADS + tidx(); i < total; i += gridDim.x * NTHREADS) {
        const int c = i % DFF, et = i / DFF, k = et >> 1, side = et & 1;
        const int t = k * 128 + (side ? 127 : 0); const int s = t & (SEQ - 1);
        const float* hk = halo + (size_t)k * 4 * 5632;
        float o[2];
#pragma unroll
        for (int fb = 0; fb < 2; ++fb) {
            const int ch = c + fb * DFF; float pv, cu, nx;
            if (side == 0) { cu = hk[ch]; nx = hk[5632 + ch]; pv = s == 0 ? 0.f : hk[ch - 5632]; }
            else { cu = hk[3 * 5632 + ch]; pv = hk[2 * 5632 + ch]; nx = s == SEQ - 1 ? 0.f : hk[4 * 5632 + ch]; }
            o[fb] = pv * cw[ch] + cu * cw[5632 + ch] + nx * cw[2 * 5632 + ch] + cb[ch];
        }
        const float a = o[0] * sigmoidf_(o[0]) * o[1];
        act[(size_t)t * DFF + c] = (bf16_t)(pk2(a, 0.f) & 0xffff);
    }
}

template <int NDB, bool NA>
DI void attn_tile(const char* ldsK, const char* ldsV, const bf16x8 (&qf)[4], f32x16 (&o)[NDB], float& m, float& l, int r, int h, const float* lbias, int qc, f32x16& sinit, bool first) {
    const int pr = (r & 0x13) | ((r & 4) << 1) | ((r & 8) >> 1);
    f32x16 s[2];
#pragma unroll
    for (int ks = 0; ks < 2; ++ks) {
        const char* kp = ldsK + (ks * 32 + pr) * LROW + h * 16;
        s[ks] = mfma32(*(const bf16x8*)kp, qf[0], sinit);
#pragma unroll
        for (int t = 1; t < 4; ++t) s[ks] = mfma32(*(const bf16x8*)(kp + t * 32), qf[t], s[ks]);
    }
    if (NA) {
        int cs = qc - 8; cs = cs < 0 ? 0 : (cs > 48 ? 48 : cs);
        int base = 8 * h - qc + 15, base2 = 8 * h - cs;
#pragma unroll
        for (int ks = 0; ks < 2; ++ks)
#pragma unroll
            for (int i = 0; i < 16; ++i) {
                const int off = 32 * ks + (i & 7) + 16 * (i >> 3);
                int d = base + off; d = d < 0 ? 0 : (d > 30 ? 30 : d);
                const bool valid = (unsigned)(base2 + off) < 16u;
                s[ks][i] = valid ? s[ks][i] + lbias[d] : -1e30f;
            }
    }
    if (first) {
        float mx = fmaxf(s[0][0], s[0][1]);
#pragma unroll
        for (int i = 2; i < 16; i += 2) mx = fmaxf(mx, fmaxf(s[0][i], s[0][i + 1]));
#pragma unroll
        for (int i = 0; i < 16; i += 2) mx = fmaxf(mx, fmaxf(s[1][i], s[1][i + 1]));
        mx = xhalf_max(mx);
        m += mx;
#pragma unroll
        for (int i = 0; i < 16; ++i) sinit[i] = -m;
#pragma unroll
        for (int ks = 0; ks < 2; ++ks)
#pragma unroll
            for (int i = 0; i < 16; ++i) s[ks][i] -= mx;
    }
    float ps0 = 0.f, ps1 = 0.f;
#pragma unroll
    for (int ks = 0; ks < 2; ++ks)
#pragma unroll
        for (int i = 0; i < 16; i += 2) { const float p0 = fexp2(s[ks][i]), p1 = fexp2(s[ks][i + 1]); ps0 += p0; ps1 += p1; s[ks][i] = p0; s[ks][i + 1] = p1; }
    float pst = ps0 + ps1;
    if (__builtin_amdgcn_ballot_w64(pst > 65536.0f) != 0ull) {
        float pm = fmaxf(s[0][0], s[0][1]);
#pragma unroll
        for (int i = 2; i < 16; i += 2) pm = fmaxf(pm, fmaxf(s[0][i], s[0][i + 1]));
#pragma unroll
        for (int i = 0; i < 16; i += 2) pm = fmaxf(pm, fmaxf(s[1][i], s[1][i + 1]));
        pm = xhalf_max(pm);
        int e = __builtin_amdgcn_frexp_expf(pm) - 1; e = e < 0 ? 0 : e;
        const float de = (float)e, alpha = fexp2(-de);
        m += de; l *= alpha; pst *= alpha;
#pragma unroll
        for (int i = 0; i < 16; ++i) sinit[i] = -m;
#pragma unroll
        for (int ks = 0; ks < 2; ++ks)
#pragma unroll
            for (int i = 0; i < 16; ++i) s[ks][i] *= alpha;
#pragma unroll
        for (int db = 0; db < NDB; ++db)
#pragma unroll
            for (int i = 0; i < 16; ++i) o[db][i] *= alpha;
    }
    l += pst;
#pragma unroll
    for (int ks = 0; ks < 2; ++ks)
#pragma unroll
        for (int sp = 0; sp < 2; ++sp) {
            u32x4 pw; pw.x = pk2(s[ks][8 * sp], s[ks][8 * sp + 1]); pw.y = pk2(s[ks][8 * sp + 2], s[ks][8 * sp + 3]); pw.z = pk2(s[ks][8 * sp + 4], s[ks][8 * sp + 5]); pw.w = pk2(s[ks][8 * sp + 6], s[ks][8 * sp + 7]);
            const bf16x8 pf = __builtin_bit_cast(bf16x8, pw);
            const char* vp = ldsV + r * LROW + (ks * 32 + sp * 16 + h * 8) * 2;
#pragma unroll
            for (int db = 0; db < NDB; ++db) o[db] = mfma32(*(const bf16x8*)(vp + db * 32 * LROW), pf, o[db]);
        }
}

constexpr int KT_BYTES = 64 * LROW;

DI void attn_gqa_unit(char* lds, const bf16_t* __restrict__ qkb, const bf16_t* __restrict__ bvt, bf16_t* __restrict__ mix, int u) {
    const int tid = tidx(), lane = tid & 63, wid = __builtin_amdgcn_readfirstlane(tid >> 6), r = lane & 31, h = lane >> 5;
    const int pair = u & 7, qb = u >> 3, b = pair >> 1, g = pair & 1;
    const int tq = b * SEQ + qb * 64 + (wid >> 2) * 32 + r;
    const int qhead = g * 4 + (wid & 3);
    bf16x8 qf[4];
#pragma unroll
    for (int t = 0; t < 4; ++t) qf[t] = *(const bf16x8*)(qkb + (size_t)tq * QLD + 1024 + qhead * 64 + 16 * t + 8 * h);
    f32x16 o[2];
#pragma unroll
    for (int db = 0; db < 2; ++db)
#pragma unroll
        for (int i = 0; i < 16; ++i) o[db][i] = 0.f;
    float m = 0.f, l = 0.f;
    f32x16 sinit;
#pragma unroll
    for (int i = 0; i < 16; ++i) sinit[i] = 0.f;
    const int lrow = tid >> 3, lkc = tid & 7, lw = lrow * LROW + lkc * 16;
    const bf16_t* gk = qkb + (size_t)(b * SEQ + lrow) * QLD + 1536 + g * 64 + lkc * 8;
    const bf16_t* gv = bvt + (size_t)((b * 2 + g) * 64 + lrow) * SEQ + lkc * 8;
    u32x4 rk = *(const u32x4*)gk, rv = *(const u32x4*)gv;
    *(u32x4*)(lds + lw) = rk; *(u32x4*)(lds + KT_BYTES + lw) = rv;
#pragma unroll
    for (int t = 0; t < 4; ++t) asm volatile("" : "+v"(qf[t]));
    __syncthreads();
    constexpr int NT = SEQ / 64;
#pragma unroll 1
    for (int it = 0; it < NT; ++it) {
        const bool more = it + 1 < NT;
        if (more) { rk = *(const u32x4*)(gk + (size_t)(it + 1) * 64 * QLD); rv = *(const u32x4*)(gv + (it + 1) * 64); }
        const char* buf = lds + (it & 1) * 2 * KT_BYTES;
        attn_tile<2, false>(buf, buf + KT_BYTES, qf, o, m, l, r, h, nullptr, 0, sinit, it == 0);
        if (more) { char* d = lds + ((it + 1) & 1) * 2 * KT_BYTES + lw; *(u32x4*)d = rk; *(u32x4*)(d + KT_BYTES) = rv; }
        __syncthreads();
    }
    l += __shfl_xor(l, 32);
    const float inv = 1.0f / l;
#pragma unroll
    for (int db = 0; db < 2; ++db)
#pragma unroll
        for (int g4 = 0; g4 < 4; ++g4)
            st_bf4(mix + (size_t)tq * DM + 512 + qhead * 64 + 32 * db + 8 * g4 + 4 * h, o[db][4 * g4] * inv, o[db][4 * g4 + 1] * inv, o[db][4 * g4 + 2] * inv, o[db][4 * g4 + 3] * inv);
}


DI void attn_gqa2_unit(char* lds, const bf16_t* __restrict__ qkb, const bf16_t* __restrict__ bvt, bf16_t* __restrict__ mix, int u) {
    const int tid = tidx(), lane = tid & 63, wid = __builtin_amdgcn_readfirstlane(tid >> 6), r = lane & 31, h = lane >> 5;
    const int pair = u & 7, qb = u >> 3, b = pair >> 1, g = pair & 1;
    const int tq0 = b * SEQ + qb * 128 + (wid >> 2) * 64 + r;
    const int qhead = g * 4 + (wid & 3);
    bf16x8 qf[2][4];
#pragma unroll
    for (int sb = 0; sb < 2; ++sb)
#pragma unroll
        for (int t = 0; t < 4; ++t) qf[sb][t] = *(const bf16x8*)(qkb + (size_t)(tq0 + 32 * sb) * QLD + 1024 + qhead * 64 + 16 * t + 8 * h);
    f32x16 o[2][2];
#pragma unroll
    for (int sb = 0; sb < 2; ++sb)
#pragma unroll
        for (int db = 0; db < 2; ++db)
#pragma unroll
            for (int i = 0; i < 16; ++i) o[sb][db][i] = 0.f;
    float m[2] = {0.f, 0.f}, l[2] = {0.f, 0.f};
    f32x16 sinit[2];
#pragma unroll
    for (int sb = 0; sb < 2; ++sb)
#pragma unroll
        for (int i = 0; i < 16; ++i) sinit[sb][i] = 0.f;
    const int lrow = tid >> 3, lkc = tid & 7, lw = lrow * LROW + lkc * 16;
    const bf16_t* gk = qkb + (size_t)(b * SEQ + lrow) * QLD + 1536 + g * 64 + lkc * 8;
    const bf16_t* gv = bvt + (size_t)((b * 2 + g) * 64 + lrow) * SEQ + lkc * 8;
    u32x4 rk = *(const u32x4*)gk, rv = *(const u32x4*)gv;
    *(u32x4*)(lds + lw) = rk; *(u32x4*)(lds + KT_BYTES + lw) = rv;
#pragma unroll
    for (int sb = 0; sb < 2; ++sb)
#pragma unroll
        for (int t = 0; t < 4; ++t) asm volatile("" : "+v"(qf[sb][t]));
    __syncthreads();
    const int pr = (r & 0x13) | ((r & 4) << 1) | ((r & 8) >> 1);
    constexpr int NT = SEQ / 64;
#pragma unroll 1
    for (int it = 0; it < NT; ++it) {
        const bool more = it + 1 < NT;
        if (more) { rk = *(const u32x4*)(gk + (size_t)(it + 1) * 64 * QLD); rv = *(const u32x4*)(gv + (it + 1) * 64); }
        const char* ldsK = lds + (it & 1) * 2 * KT_BYTES; const char* ldsV = ldsK + KT_BYTES;
        f32x16 s[2][2];
#pragma unroll
        for (int ks = 0; ks < 2; ++ks) {
            const char* kp = ldsK + (ks * 32 + pr) * LROW + h * 16;
            { const bf16x8 kf = *(const bf16x8*)kp; s[0][ks] = mfma32(kf, qf[0][0], sinit[0]); s[1][ks] = mfma32(kf, qf[1][0], sinit[1]); }
#pragma unroll
            for (int t = 1; t < 4; ++t) { const bf16x8 kf = *(const bf16x8*)(kp + t * 32); s[0][ks] = mfma32(kf, qf[0][t], s[0][ks]); s[1][ks] = mfma32(kf, qf[1][t], s[1][ks]); }
        }
        u32x4 pw[2][2][2];
#pragma unroll
        for (int sb = 0; sb < 2; ++sb) {
            if (it == 0) {
                float mx = fmaxf(s[sb][0][0], s[sb][0][1]);
#pragma unroll
                for (int i = 2; i < 16; i += 2) mx = fmaxf(mx, fmaxf(s[sb][0][i], s[sb][0][i + 1]));
#pragma unroll
                for (int i = 0; i < 16; i += 2) mx = fmaxf(mx, fmaxf(s[sb][1][i], s[sb][1][i + 1]));
                mx = xhalf_max(mx);
                m[sb] += mx;
#pragma unroll
                for (int i = 0; i < 16; ++i) sinit[sb][i] = -m[sb];
#pragma unroll
                for (int ks = 0; ks < 2; ++ks)
#pragma unroll
                    for (int i = 0; i < 16; ++i) s[sb][ks][i] -= mx;
            }
            float ps0 = 0.f, ps1 = 0.f;
#pragma unroll
            for (int ks = 0; ks < 2; ++ks)
#pragma unroll
                for (int i = 0; i < 16; i += 2) { const float p0 = fexp2(s[sb][ks][i]), p1 = fexp2(s[sb][ks][i + 1]); ps0 += p0; ps1 += p1; s[sb][ks][i] = p0; s[sb][ks][i + 1] = p1; }
            float pst = ps0 + ps1;
            if (__builtin_amdgcn_ballot_w64(pst > 65536.0f) != 0ull) {
                float pm = fmaxf(s[sb][0][0], s[sb][0][1]);
#pragma unroll
                for (int i = 2; i < 16; i += 2) pm = fmaxf(pm, fmaxf(s[sb][0][i], s[sb][0][i + 1]));
#pragma unroll
                for (int i = 0; i < 16; i += 2) pm = fmaxf(pm, fmaxf(s[sb][1][i], s[sb][1][i + 1]));
                pm = xhalf_max(pm);
                int e = __builtin_amdgcn_frexp_expf(pm) - 1; e = e < 0 ? 0 : e;
                const float de = (float)e, alpha = fexp2(-de);
                m[sb] += de; l[sb] *= alpha; pst *= alpha;
#pragma unroll
                for (int i = 0; i < 16; ++i) sinit[sb][i] = -m[sb];
#pragma unroll
                for (int ks = 0; ks < 2; ++ks)
#pragma unroll
                    for (int i = 0; i < 16; ++i) s[sb][ks][i] *= alpha;
#pragma unroll
                for (int db = 0; db < 2; ++db)
#pragma unroll
                    for (int i = 0; i < 16; ++i) o[sb][db][i] *= alpha;
            }
            l[sb] += pst;
#pragma unroll
            for (int ks = 0; ks < 2; ++ks)
#pragma unroll
                for (int sp = 0; sp < 2; ++sp) {
                    pw[sb][ks][sp].x = pk2(s[sb][ks][8 * sp], s[sb][ks][8 * sp + 1]); pw[sb][ks][sp].y = pk2(s[sb][ks][8 * sp + 2], s[sb][ks][8 * sp + 3]);
                    pw[sb][ks][sp].z = pk2(s[sb][ks][8 * sp + 4], s[sb][ks][8 * sp + 5]); pw[sb][ks][sp].w = pk2(s[sb][ks][8 * sp + 6], s[sb][ks][8 * sp + 7]);
                }
        }
#pragma unroll
        for (int ks = 0; ks < 2; ++ks)
#pragma unroll
            for (int sp = 0; sp < 2; ++sp) {
                const char* vp = ldsV + r * LROW + (ks * 32 + sp * 16 + h * 8) * 2;
#pragma unroll
                for (int db = 0; db < 2; ++db) {
                    const bf16x8 vf = *(const bf16x8*)(vp + db * 32 * LROW);
                    o[0][db] = mfma32(vf, __builtin_bit_cast(bf16x8, pw[0][ks][sp]), o[0][db]);
                    o[1][db] = mfma32(vf, __builtin_bit_cast(bf16x8, pw[1][ks][sp]), o[1][db]);
                }
            }
        if (more) { char* d = lds + ((it + 1) & 1) * 2 * KT_BYTES + lw; *(u32x4*)d = rk; *(u32x4*)(d + KT_BYTES) = rv; }
        __syncthreads();
    }
#pragma unroll
    for (int sb = 0; sb < 2; ++sb) {
        const float lt = l[sb] + __shfl_xor(l[sb], 32);
        const float inv = 1.0f / lt;
#pragma unroll
        for (int db = 0; db < 2; ++db)
#pragma unroll
            for (int g4 = 0; g4 < 4; ++g4)
                st_bf4(mix + (size_t)(tq0 + 32 * sb) * DM + 512 + qhead * 64 + 32 * db + 8 * g4 + 4 * h, o[sb][db][4 * g4] * inv, o[sb][db][4 * g4 + 1] * inv, o[sb][db][4 * g4 + 2] * inv, o[sb][db][4 * g4 + 3] * inv);
    }
}

DI void attn_diff_unit(char* lds, const bf16_t* __restrict__ qkb, const bf16_t* __restrict__ avt, bf16_t* __restrict__ mix, int u, float lam, float lam_init, const float* __restrict__ subln) {
    const int tid = tidx(), lane = tid & 63, wid = __builtin_amdgcn_readfirstlane(tid >> 6), r = lane & 31, h = lane >> 5;
    const int pair = (u & 7) + 8 * (u >> 9), qb = ((u >> 3) & 31) + 32 * ((u >> 8) & 1), b = pair >> 2, hd = pair & 3;
    const int j = wid >> 2, qs = wid & 3;
    const int tq = b * SEQ + qb * 128 + qs * 32 + r;
    bf16x8 qf[4];
#pragma unroll
    for (int t = 0; t < 4; ++t) qf[t] = *(const bf16x8*)(qkb + (size_t)tq * QLD + (2 * hd + j) * 64 + 16 * t + 8 * h);
    f32x16 o[4];
#pragma unroll
    for (int db = 0; db < 4; ++db)
#pragma unroll
        for (int i = 0; i < 16; ++i) o[db][i] = 0.f;
    float m = 0.f, l = 0.f;
    f32x16 sinit;
#pragma unroll
    for (int i = 0; i < 16; ++i) sinit[i] = 0.f;
    const int lrow = tid >> 3, lkc = tid & 7, lw = lrow * LROW + lkc * 16;
    const bf16_t* gk = qkb + (size_t)(b * SEQ + lrow) * QLD + 512 + (2 * hd) * 64 + lkc * 8;
    const bf16_t* gv = avt + (size_t)((b * 4 + hd) * 128 + lrow) * SEQ + lkc * 8;
    constexpr int STG = 4 * KT_BYTES;
    u32x4 r0 = *(const u32x4*)gk, r1 = *(const u32x4*)(gk + 64), r2 = *(const u32x4*)gv, r3 = *(const u32x4*)(gv + (size_t)64 * SEQ);
    *(u32x4*)(lds + lw) = r0; *(u32x4*)(lds + KT_BYTES + lw) = r1; *(u32x4*)(lds + 2 * KT_BYTES + lw) = r2; *(u32x4*)(lds + 3 * KT_BYTES + lw) = r3;
#pragma unroll
    for (int t = 0; t < 4; ++t) asm volatile("" : "+v"(qf[t]));
    __syncthreads();
    constexpr int NT = SEQ / 64;
#pragma unroll 1
    for (int it = 0; it < NT; ++it) {
        const bool more = it + 1 < NT;
        if (more) { const bf16_t* k2 = gk + (size_t)(it + 1) * 64 * QLD; const bf16_t* v2 = gv + (it + 1) * 64; r0 = *(const u32x4*)k2; r1 = *(const u32x4*)(k2 + 64); r2 = *(const u32x4*)v2; r3 = *(const u32x4*)(v2 + (size_t)64 * SEQ); }
        const char* buf = lds + (it & 1) * STG;
        attn_tile<4, false>(buf + j * KT_BYTES, buf + 2 * KT_BYTES, qf, o, m, l, r, h, nullptr, 0, sinit, it == 0);
        if (more) { char* d = lds + ((it + 1) & 1) * STG + lw; *(u32x4*)d = r0; *(u32x4*)(d + KT_BYTES) = r1; *(u32x4*)(d + 2 * KT_BYTES) = r2; *(u32x4*)(d + 3 * KT_BYTES) = r3; }
        __syncthreads();
    }
    l += __shfl_xor(l, 32);
    const float inv = 1.0f / l;
    float* xch = (float*)lds;
    if (j == 1) {
#pragma unroll
        for (int db = 0; db < 4; ++db)
#pragma unroll
            for (int i = 0; i < 16; ++i) xch[((qs * 4 + db) * 16 + i) * 64 + lane] = o[db][i] * inv;
    }
    __syncthreads();
    if (j == 0) {
        float ss = 0.f;
#pragma unroll
        for (int db = 0; db < 4; ++db)
#pragma unroll
            for (int i = 0; i < 16; ++i) { const float v = o[db][i] * inv - lam * xch[((qs * 4 + db) * 16 + i) * 64 + lane]; o[db][i] = v; ss += v * v; }
        ss += __shfl_xor(ss, 32);
        const float rs = __builtin_amdgcn_rsqf(ss * (1.0f / 128.0f) + EPS) * (1.0f - lam_init);
#pragma unroll
        for (int db = 0; db < 4; ++db)
#pragma unroll
            for (int g4 = 0; g4 < 4; ++g4) {
                const int d = 32 * db + 8 * g4 + 4 * h; const f32x4 gv4 = *(const f32x4*)(subln + d);
                st_bf4(mix + (size_t)tq * DM + hd * 128 + d, o[db][4 * g4] * rs * gv4[0], o[db][4 * g4 + 1] * rs * gv4[1], o[db][4 * g4 + 2] * rs * gv4[2], o[db][4 * g4 + 3] * rs * gv4[3]);
            }
    }
    __syncthreads();
}

DI void attn_na_unit(char* lds, const bf16_t* __restrict__ qkb, const bf16_t* __restrict__ cvt, bf16_t* __restrict__ mix, int u, const float* __restrict__ bias) {
    const int tid = tidx(), lane = tid & 63, wid = __builtin_amdgcn_readfirstlane(tid >> 6), r = lane & 31, h = lane >> 5;
    const int hg = u & 3, R = (u >> 2) & 127, b = u >> 9;
    const int hw = wid & 3, head = 4 * hg + hw, qc = (wid >> 2) * 32 + r;
    const int tq = b * SEQ + R * 64 + qc;
    int rs = R - 4; rs = rs < 0 ? 0 : (rs > 120 ? 120 : rs);
    constexpr int STG = 8 * KT_BYTES;
    bf16x8 qf[4];
#pragma unroll
    for (int t = 0; t < 4; ++t) qf[t] = *(const bf16x8*)(qkb + (size_t)tq * QLD + head * 64 + 16 * t + 8 * h);
    f32x16 o[2];
#pragma unroll
    for (int db = 0; db < 2; ++db)
#pragma unroll
        for (int i = 0; i < 16; ++i) o[db][i] = 0.f;
    float m = 0.f, l = 0.f;
    f32x16 sinit;
#pragma unroll
    for (int i = 0; i < 16; ++i) sinit[i] = 0.f;
    const int lrow = tid >> 3, lkc = tid & 7, lw = lrow * LROW + lkc * 16;
    const bf16_t* gk = qkb + (size_t)(b * SEQ + rs * 64 + lrow) * QLD + 1024 + (4 * hg) * 64 + lkc * 8;
    const bf16_t* gv = cvt + (size_t)((b * 16 + 4 * hg) * 64 + lrow) * SEQ + rs * 64 + lkc * 8;
    float* lb = (float*)(lds + 4 * GT_BYTES);
    for (int i = tid; i < 4 * 465; i += NTHREADS) lb[i] = bias[(size_t)hg * 4 * 465 + i] * LOG2E;
    u32x4 rk[4], rv[4];
#pragma unroll
    for (int hd = 0; hd < 4; ++hd) { rk[hd] = *(const u32x4*)(gk + 64 * hd); rv[hd] = *(const u32x4*)(gv + (size_t)hd * 64 * SEQ); }
#pragma unroll
    for (int hd = 0; hd < 4; ++hd) { *(u32x4*)(lds + (2 * hd) * KT_BYTES + lw) = rk[hd]; *(u32x4*)(lds + (2 * hd + 1) * KT_BYTES + lw) = rv[hd]; }
#pragma unroll
    for (int t = 0; t < 4; ++t) asm volatile("" : "+v"(qf[t]));
    __syncthreads();
#pragma unroll 1
    for (int it = 0; it < 8; ++it) {
        const bool more = it + 1 < 8;
        if (more) {
#pragma unroll
            for (int hd = 0; hd < 4; ++hd) { rk[hd] = *(const u32x4*)(gk + (size_t)(it + 1) * 64 * QLD + 64 * hd); rv[hd] = *(const u32x4*)(gv + (size_t)hd * 64 * SEQ + (it + 1) * 64); }
        }
        const char* buf = lds + (it & 1) * STG + (2 * hw) * KT_BYTES;
        const float* brow = lb + (hw * 15 + (rs + it - R + 7)) * 31;
        attn_tile<2, true>(buf, buf + KT_BYTES, qf, o, m, l, r, h, brow, qc, sinit, it == 0);
        if (more) {
            char* d = lds + ((it + 1) & 1) * STG + lw;
#pragma unroll
            for (int hd = 0; hd < 4; ++hd) { *(u32x4*)(d + (2 * hd) * KT_BYTES) = rk[hd]; *(u32x4*)(d + (2 * hd + 1) * KT_BYTES) = rv[hd]; }
        }
        __syncthreads();
    }
    l += __shfl_xor(l, 32);
    const float inv = 1.0f / l;
#pragma unroll
    for (int db = 0; db < 2; ++db)
#pragma unroll
        for (int g4 = 0; g4 < 4; ++g4)
            st_bf4(mix + (size_t)tq * DM + head * 64 + 32 * db + 8 * g4 + 4 * h, o[db][4 * g4] * inv, o[db][4 * g4 + 1] * inv, o[db][4 * g4 + 2] * inv, o[db][4 * g4 + 3] * inv);
}


#define XB_TMO      128
#define XB_XCNT(j)  (256  + 64 * (j))
#define XB_XSUB(j)  (1280 + 64 * (j))
#define XB_XGEN(j)  (2304 + 64 * (j))
#define XB_TOP      3328
#define XB_TOPGEN   3392
#define XCD_BAR_WORDS 3456
#define XB_SPIN_CAP (1u << 23)
#define LAS __attribute__((address_space(3)))
DI unsigned xb_ld(unsigned* p)              { return __hip_atomic_load(p, __ATOMIC_RELAXED, __HIP_MEMORY_SCOPE_AGENT); }
DI unsigned xb_add(unsigned* p, unsigned v) { return __hip_atomic_fetch_add(p, v, __ATOMIC_RELAXED, __HIP_MEMORY_SCOPE_AGENT); }
DI unsigned xb_xcc_id() { return (unsigned)__builtin_amdgcn_s_getreg((3 << 11) | 20) & 0xFu; }
#define XB_SPIN(cond, bar) do { unsigned _sp = 0; while (cond) { __builtin_amdgcn_s_sleep(1); \
    if ((++_sp & 255u) == 0u) { if (xb_ld(&(bar)[XB_TMO])) break; if (_sp > XB_SPIN_CAP) { atomicAdd(&(bar)[XB_TMO], 1u); break; } } } } while (0)
struct XcdBarrier { unsigned* bar; unsigned x; volatile LAS unsigned* st; unsigned slot; };
DI XcdBarrier xcd_barrier_post(unsigned* bar, volatile LAS unsigned* st) {
    XcdBarrier b; b.bar = bar; b.x = xb_xcc_id(); b.st = st; b.slot = 0u;
    if (threadIdx.x == 0) b.slot = xb_add(&bar[XB_XCNT(b.x)], 1u);
    return b;
}
DI void xcd_barrier_complete(unsigned* bar, unsigned x, unsigned& nloc, unsigned& nx) {
    const unsigned G = gridDim.x * gridDim.y * gridDim.z;
    unsigned sum, cnt, mine, sp = 0u;
    for (;;) {
        sum = 0u; cnt = 0u; mine = 0u;
#pragma unroll
        for (unsigned j = 0; j < 16; ++j) { const unsigned c = xb_ld(&bar[XB_XCNT(j)]); sum += c; cnt += (c > 0u) ? 1u : 0u; mine = (j == x) ? c : mine; }
        if (sum == G) break;
        __builtin_amdgcn_s_sleep(1);
        if ((++sp & 255u) == 0u) { if (xb_ld(&bar[XB_TMO])) break; if (sp > XB_SPIN_CAP) { atomicAdd(&bar[XB_TMO], 1u); break; } }
    }
    nloc = mine > 0u ? mine : 1u; nx = cnt > 0u ? cnt : 1u;
}
DI void xcd_barrier(const XcdBarrier& b) {
    asm volatile("s_waitcnt vmcnt(0)" ::: "memory");
    __syncthreads();
    if (threadIdx.x == 0) {
        unsigned* bar = b.bar;
        __builtin_amdgcn_s_waitcnt(0);
        unsigned nloc = b.st[0], nx = b.st[1];
        if (nloc == 0u) { xcd_barrier_complete(bar, b.x, nloc, nx); b.st[0] = nloc; b.st[1] = nx; }
        const unsigned old = xb_add(&bar[XB_XSUB(b.x)], 1u);
        const unsigned gen = old / nloc;
        if (old + 1u == (gen + 1u) * nloc) {
            __builtin_amdgcn_fence(__ATOMIC_RELEASE, "agent");
            asm volatile("s_waitcnt vmcnt(0)" ::: "memory");
            const unsigned og = xb_add(&bar[XB_TOP], 1u);
            const unsigned tg = og / nx;
            if (og + 1u == (tg + 1u) * nx) xb_add(&bar[XB_TOPGEN], 1u);
            else XB_SPIN(xb_ld(&bar[XB_TOPGEN]) == tg, bar);
            __builtin_amdgcn_fence(__ATOMIC_ACQUIRE, "agent");
            xb_add(&bar[XB_XGEN(b.x)], 1u);
            asm volatile("s_waitcnt vmcnt(0)" ::: "memory");
        } else {
            XB_SPIN(xb_ld(&bar[XB_XGEN(b.x)]) == gen, bar);
            __builtin_amdgcn_fence(__ATOMIC_ACQUIRE, "agent");
            asm volatile("s_waitcnt vmcnt(0)" ::: "memory");
        }
    }
    __syncthreads();
}

__global__ void __launch_bounds__(NTHREADS) fwd_megakernel(Params P) {
    extern __shared__ __attribute__((aligned(16))) char lds[];
    cg::grid_group grid = cg::this_grid();
    volatile LAS unsigned* xst = (volatile LAS unsigned*)(lds + LDS_BYTES - 16);
    if (threadIdx.x == 0) { xst[0] = 0u; xst[1] = 0u; }
    __syncthreads();
    const XcdBarrier xb = xcd_barrier_post((unsigned*)(P.ws + OFF_BAR), xst);
    char* ws = P.ws;
    bf16_t* H = (bf16_t*)(ws + OFF_H); bf16_t* QKB = (bf16_t*)(ws + OFF_QKB); bf16_t* VT = (bf16_t*)(ws + OFF_VT);
    bf16_t* ACT = (bf16_t*)(ws + OFF_ACT); bf16_t* MIX = (bf16_t*)(ws + OFF_MIX); float* HALO = (float*)(ws + OFF_HALO); bf16_t* PB = (bf16_t*)(ws + OFF_PB);
    const f32x2* ROPEA = (const f32x2*)(ws + OFF_ROPEA); const f32x2* ROPEB = (const f32x2*)(ws + OFF_ROPEB);
    float* X = P.out;
    bf16_t* AVT = VT; bf16_t* BVT = VT + (size_t)4 * 4 * 128 * SEQ;

    float* SSQ = (float*)(ws + OFF_SSQ);
    phase_prep(P, lds);
    phase_x0(P.x, MIX, SSQ);
    phase_cvt_p(P.p, PB);
    grid.sync();
    int vbid = blockIdx.x;
    {
        volatile LAS unsigned* vst = (volatile LAS unsigned*)(lds + LDS_BYTES - 32);
        if (threadIdx.x == 0) {
            unsigned* bar = (unsigned*)(P.ws + OFF_BAR); bool ok = (gridDim.x & 7) == 0;
            for (unsigned jx = 0; jx < 16; ++jx) { const unsigned c = xb_ld(&bar[XB_XCNT(jx)]); ok = ok && (c == (jx < 8 ? gridDim.x / 8 : 0u)); }
            vst[0] = ok ? xb.slot * 8u + xb.x : blockIdx.x;
        }
        __syncthreads();
        vbid = (int)vst[0];
        __syncthreads();
    }

#pragma unroll 1
    for (int l = 0; l < 4; ++l) {
        const bf16_t* wl = (const bf16_t*)(ws + OFF_WB) + (size_t)l * WL_ELEMS; const int j = l >> 1;
        const float* xres = l == 0 ? P.x : X;
        float* ssq_a = SSQ + (size_t)(3 * l) * T_TOK * 16; float* ssq_f = ssq_a + (size_t)T_TOK * 16; float* ssq_p = ssq_f + (size_t)T_TOK * 16; float* ssq_n = ssq_p + (size_t)T_TOK * 16;
        if ((l & 1) == 0) {
            EpiInEven e{QKB, AVT, BVT, ROPEA, ROPEB, P.bq_norm + j * 64, P.bk_norm + j * 64, ssq_a};
            gemm_phase(lds, MIX, DM, wl + WL_WIN, 1024, 2304, e, vbid);
            xcd_barrier(xb);
            const float lam_init = j == 0 ? P.lam_init[0] : P.lam_init[1];
            float lam;
            { const int lane = threadIdx.x & 63; float a = P.lq1[j * 64 + lane] * P.lk1[j * 64 + lane], c = P.lq2[j * 64 + lane] * P.lk2[j * 64 + lane];
#pragma unroll
              for (int o = 32; o >= 1; o >>= 1) { a += __shfl_xor(a, o); c += __shfl_xor(c, o); }
              lam = __expf(a) - __expf(c) + lam_init;
              lam = __builtin_bit_cast(float, __builtin_amdgcn_readfirstlane(__builtin_bit_cast(int, lam))); }
            for (int u = vbid; u < 1536; u += gridDim.x) {
                if (u < 1024) attn_diff_unit(lds, QKB, AVT, MIX, u, lam, lam_init, P.a_subln + j * 128);
                else attn_gqa2_unit(lds, QKB, BVT, MIX, u - 1024);
            }
            xcd_barrier(xb);
        } else {
            EpiInOdd e{QKB, VT, ssq_a};
            gemm_phase(lds, MIX, DM, wl + WL_WIN, 1024, 3072, e, vbid);
            xcd_barrier(xb);
            for (int u = vbid; u < 2048; u += gridDim.x) attn_na_unit(lds, QKB, VT, MIX, u, P.c_rel_bias + (size_t)j * 16 * 15 * 31);
            xcd_barrier(xb);
        }
        { EpiResid e{xres, X, H, ssq_f}; gemm_phase(lds, MIX, DM, wl + WL_WOUT, 1024, 1024, e, vbid); }
        xcd_barrier(xb);
        { EpiUp e{ACT, HALO, P.conv_w + (size_t)l * 3 * 5632, P.conv_b + (size_t)l * 5632, ssq_f}; gemm_phase(lds, H, DM, wl + WL_WUP, 1024, 5632, e, vbid); }
        { EpiBf16 e{MIX}; gemm_phase(lds, PB, PLE, wl + WL_WPROJ, 256, 1024, e, vbid); }
        xcd_barrier(xb);
        phase_fix(HALO, ACT, P.conv_w + (size_t)l * 3 * 5632, P.conv_b + (size_t)l * 5632);
        if (l < 3) phase_cvt_p(P.p + (size_t)(l + 1) * T_TOK * PLE, PB);
        xcd_barrier(xb);
        { EpiResid e{X, X, H, ssq_p}; gemm_phase(lds, ACT, DFF, wl + WL_WDOWN, 2816, 1024, e, vbid); }
        xcd_barrier(xb);
        { EpiPle e{X, MIX, ssq_p, ssq_n}; gemm_phase(lds, H, DM, wl + WL_WGATE, 1024, 1024, e, vbid); }
        xcd_barrier(xb);
    }
    phase_final_norm(X, P.final_norm);
}

extern "C" void kernel_launch(void* const* d_in, const int* in_sizes, int n_in, void* d_out, int out_size, void* d_ws, size_t ws_size, hipStream_t stream) {
    static int grid_blocks = 0;
    if (!grid_blocks) {
        int dev = 0, cus = 0, per_cu = 0;
        hipGetDevice(&dev);
        hipDeviceGetAttribute(&cus, hipDeviceAttributeMultiprocessorCount, dev);
        if (hipFuncSetAttribute((const void*)fwd_megakernel, hipFuncAttributeMaxDynamicSharedMemorySize, LDS_BYTES) != hipSuccess) fprintf(stderr, "hipFuncSetAttribute failed\n");
        hipOccupancyMaxActiveBlocksPerMultiprocessor(&per_cu, (const void*)fwd_megakernel, NTHREADS, LDS_BYTES);
        if (per_cu < 1) { fprintf(stderr, "occupancy query returned %d\n", per_cu); per_cu = 1; }
        grid_blocks = cus * 1;
    }
    if (ws_size < WS_NEEDED) { fprintf(stderr, "workspace too small: %zu < %zu\n", ws_size, (size_t)WS_NEEDED); return; }
    Params P{};
    const float* const* in = (const float* const*)d_in;
    P.x = in[0]; P.p = in[1]; P.attn_norm = in[2]; P.w_in_ab = in[3]; P.lq1 = in[4]; P.lk1 = in[5]; P.lq2 = in[6]; P.lk2 = in[7];
    P.a_subln = in[8]; P.bq_norm = in[9]; P.bk_norm = in[10]; P.w_out_ab = in[11]; P.w_in_c = in[12]; P.c_rel_bias = in[13]; P.w_out_c = in[14];
    P.ffn_norm = in[15]; P.w_ffn_up = in[16]; P.conv_w = in[17]; P.conv_b = in[18]; P.w_ffn_down = in[19]; P.ple_norm = in[20];
    P.w_ple_gate = in[21]; P.w_ple_proj = in[22]; P.final_norm = in[23];
    P.out = (float*)d_out; P.ws = (char*)d_ws;
    for (int i = 0; i < 8; ++i) P.inv_a[i] = powf(500000.0f, -(float)i / 8.0f);
    for (int i = 0; i < 16; ++i) P.inv_b[i] = powf(10000.0f, -(float)i / 16.0f);
    P.lam_init[0] = (float)(0.8 - 0.6 * exp(-0.3 * 0.0)); P.lam_init[1] = (float)(0.8 - 0.6 * exp(-0.3 * 2.0)); P.lam_init[2] = 0.f; P.lam_init[3] = 0.f;
    hipMemsetAsync((char*)d_ws + OFF_BAR, 0, 16384, stream);
    void* args[] = {&P};
    hipError_t e = hipLaunchCooperativeKernel((const void*)fwd_megakernel, dim3(grid_blocks), dim3(NTHREADS), args, LDS_BYTES, stream);
    if (e != hipSuccess) fprintf(stderr, "cooperative launch failed: %s (grid %d)\n", hipGetErrorString(e), grid_blocks);
}
```
